# Optimizing an MI355X kernel written in HIP

```python
import jax, jax.numpy as jnp
from jax import lax
import numpy as np

D_MODEL = 1024
BATCH = 16
SEQ = 2048
DEPTH = 2

N_EVEN = (DEPTH + 1) // 2
N_ODD = DEPTH // 2
D_A = D_MODEL // 2
CONV_A_WIDTH = 31
D_B = D_MODEL // 2
CONV_B_WIDTH = 3
CONV_IN = 2 * D_A + 3 * D_B
GLA_HEADS = 4
GLA_DK = D_MODEL // 2 // GLA_HEADS
GLA_DV = D_MODEL // GLA_HEADS
GATE_RANK = 16
GATE_TAU = 16.0
CHUNK = 64
GLA_IN = 2 * GLA_HEADS * GLA_DK + 2 * GLA_HEADS * GLA_DV + 2 * GATE_RANK
D_FF = ((8 * D_MODEL // 3 + 255) // 256) * 256
EPS = 1e-6

kernel_name = "hybrid_conv_gla_encoder"


def rms_norm(x, g):
    xf = x.astype(jnp.float32)
    y = xf * lax.rsqrt(jnp.mean(xf * xf, axis=-1, keepdims=True) + EPS)
    return (y * g.astype(jnp.float32)).astype(x.dtype)


def layer_norm(x, g, b):
    xf = x.astype(jnp.float32)
    mu = jnp.mean(xf, axis=-1, keepdims=True)
    xc = xf - mu
    y = xc * lax.rsqrt(jnp.mean(xc * xc, axis=-1, keepdims=True) + EPS)
    return (y * g.astype(jnp.float32) + b.astype(jnp.float32)).astype(x.dtype)


def depthwise_conv(x, w):
    k = w.shape[0]
    pad = (k - 1) // 2
    return lax.conv_general_dilated(
        x, w[:, None, :].astype(x.dtype), window_strides=(1,), padding=[(pad, pad)],
        dimension_numbers=("NWC", "WIO", "NWC"), feature_group_count=x.shape[-1])


def conv_hybrid_mixer(h, w_in, dw_w, dw_b, ln_g, ln_b, sc_w, w_out):
    u = h @ w_in
    a_val, a_gate, b_gate, c_gate, v = jnp.split(
        u, [D_A, 2 * D_A, 2 * D_A + D_B, 2 * D_A + 2 * D_B], axis=-1)
    a = a_val * jax.nn.sigmoid(a_gate)
    a = depthwise_conv(a, dw_w) + dw_b
    a = jax.nn.silu(layer_norm(a, ln_g, ln_b))
    bb = b_gate * depthwise_conv(c_gate * v, sc_w)
    return jnp.concatenate([a, bb], axis=-1) @ w_out


def gla_one_direction(q, k, v, log_a):
    b_, s_, h_, dk = q.shape
    dv = v.shape[-1]
    n = s_ // CHUNK
    qf = q.astype(jnp.float32).reshape(b_, n, CHUNK, h_, dk) * (dk ** -0.5)
    kf = k.astype(jnp.float32).reshape(b_, n, CHUNK, h_, dk)
    vf = v.astype(jnp.float32).reshape(b_, n, CHUNK, h_, dv)
    cum = jnp.cumsum(log_a.reshape(b_, n, CHUNK, h_, dk), axis=2)
    cum_last = cum[:, :, -1:]
    q_t = qf * jnp.exp(cum)
    k_t = kf * jnp.exp(-cum)
    k_end = kf * jnp.exp(cum_last - cum)
    scores = jnp.einsum("bnihk,bnjhk->bnhij", q_t, k_t)
    mask = jnp.tril(jnp.ones((CHUNK, CHUNK), dtype=bool))
    scores = jnp.where(mask, scores, 0.0)
    o_intra = jnp.einsum("bnhij,bnjhv->bnihv", scores, vf)
    kv = jnp.einsum("bnjhk,bnjhv->nbhkv", k_end, vf)
    decay = jnp.transpose(jnp.exp(cum_last[:, :, 0]), (1, 0, 2, 3))

    def step(state, inp):
        d, kv_n = inp
        return state * d[..., None] + kv_n, state

    _, states = lax.scan(step, jnp.zeros((b_, h_, dk, dv), jnp.float32), (decay, kv))
    o_inter = jnp.einsum("bnihk,nbhkv->bnihv", q_t, states)
    return (o_intra + o_inter).reshape(b_, s_, h_, dv)


def gla_mixer(h, w_in, wa2_f, ba2_f, wa2_b, ba2_b, gn_g, w_out):
    b_, s_, _ = h.shape
    u = h @ w_in
    qd = GLA_HEADS * GLA_DK
    vd = GLA_HEADS * GLA_DV
    q, k, v, r, g_f, g_b = jnp.split(
        u, [qd, 2 * qd, 2 * qd + vd, 2 * qd + 2 * vd, 2 * qd + 2 * vd + GATE_RANK], axis=-1)
    q = q.reshape(b_, s_, GLA_HEADS, GLA_DK)
    k = k.reshape(b_, s_, GLA_HEADS, GLA_DK)
    v = v.reshape(b_, s_, GLA_HEADS, GLA_DV)
    la_f = (jax.nn.log_sigmoid((g_f @ wa2_f + ba2_f).astype(jnp.float32)) / GATE_TAU)
    la_b = (jax.nn.log_sigmoid((g_b @ wa2_b + ba2_b).astype(jnp.float32)) / GATE_TAU)
    la_f = la_f.reshape(b_, s_, GLA_HEADS, GLA_DK)
    la_b = la_b.reshape(b_, s_, GLA_HEADS, GLA_DK)
    o_fwd = gla_one_direction(q, k, v, la_f)
    o_bwd = jnp.flip(gla_one_direction(jnp.flip(q, 1), jnp.flip(k, 1), jnp.flip(v, 1),
                                       jnp.flip(la_b, 1)), 1)
    o = o_fwd + o_bwd
    o = o * lax.rsqrt(jnp.mean(o * o, axis=-1, keepdims=True) + EPS)
    o = o * gn_g.astype(jnp.float32).reshape(GLA_HEADS, GLA_DV)
    o = o.reshape(b_, s_, GLA_HEADS * GLA_DV) * jax.nn.silu(r.astype(jnp.float32))
    return o.astype(h.dtype) @ w_out


def swiglu_ffn(h, w_gu, w_down):
    gu = h @ w_gu
    g, u = jnp.split(gu, 2, axis=-1)
    return (jax.nn.silu(g) * u) @ w_down


def setup_inputs(seed: int = 0) -> dict:
    key = jax.random.key(seed)
    ks = jax.random.split(key, 24)
    f32 = jnp.float32

    def nrm(k, shape, scale):
        return jax.random.normal(k, shape, f32) * scale

    def gain(k, shape):
        return 1.0 + 0.02 * jax.random.normal(k, shape, f32)

    return {
        "x": jax.random.normal(ks[0], (BATCH, SEQ, D_MODEL), f32),
        "mix_pre_g": gain(ks[1], (DEPTH, D_MODEL)),
        "mix_post_g": gain(ks[2], (DEPTH, D_MODEL)),
        "ffn_pre_g": gain(ks[3], (DEPTH, D_MODEL)),
        "ffn_post_g": gain(ks[4], (DEPTH, D_MODEL)),
        "cv_w_in": nrm(ks[5], (N_EVEN, D_MODEL, CONV_IN), D_MODEL ** -0.5),
        "cv_dw_w": nrm(ks[6], (N_EVEN, CONV_A_WIDTH, D_A), CONV_A_WIDTH ** -0.5),
        "cv_dw_b": nrm(ks[7], (N_EVEN, D_A), 0.02),
        "cv_ln_g": gain(ks[8], (N_EVEN, D_A)),
        "cv_ln_b": nrm(ks[9], (N_EVEN, D_A), 0.02),
        "cv_sc_w": nrm(ks[10], (N_EVEN, CONV_B_WIDTH, D_B), CONV_B_WIDTH ** -0.5),
        "cv_w_out": nrm(ks[11], (N_EVEN, D_A + D_B, D_MODEL), (D_A + D_B) ** -0.5),
        "gla_w_in": nrm(ks[12], (N_ODD, D_MODEL, GLA_IN), D_MODEL ** -0.5),
        "gla_wa2_f": nrm(ks[13], (N_ODD, GATE_RANK, GLA_HEADS * GLA_DK), GATE_RANK ** -0.5),
        "gla_ba2_f": nrm(ks[14], (N_ODD, GLA_HEADS * GLA_DK), 0.1),
        "gla_wa2_b": nrm(ks[15], (N_ODD, GATE_RANK, GLA_HEADS * GLA_DK), GATE_RANK ** -0.5),
        "gla_ba2_b": nrm(ks[16], (N_ODD, GLA_HEADS * GLA_DK), 0.1),
        "gla_gn_g": gain(ks[17], (N_ODD, GLA_HEADS * GLA_DV)),
        "gla_w_out": nrm(ks[18], (N_ODD, GLA_HEADS * GLA_DV, D_MODEL), (GLA_HEADS * GLA_DV) ** -0.5),
        "ffn_w_gu": nrm(ks[19], (DEPTH, D_MODEL, 2 * D_FF), D_MODEL ** -0.5),
        "ffn_w_down": nrm(ks[20], (DEPTH, D_FF, D_MODEL), D_FF ** -0.5),
    }


def reference(x, mix_pre_g, mix_post_g, ffn_pre_g, ffn_post_g,
              cv_w_in, cv_dw_w, cv_dw_b, cv_ln_g, cv_ln_b, cv_sc_w, cv_w_out,
              gla_w_in, gla_wa2_f, gla_ba2_f, gla_wa2_b, gla_ba2_b, gla_gn_g, gla_w_out,
              ffn_w_gu, ffn_w_down):
    for layer in range(DEPTH):
        h = rms_norm(x, mix_pre_g[layer])
        if layer % 2 == 0:
            i = layer // 2
            m = conv_hybrid_mixer(h, cv_w_in[i], cv_dw_w[i], cv_dw_b[i], cv_ln_g[i],
                                  cv_ln_b[i], cv_sc_w[i], cv_w_out[i])
        else:
            i = layer // 2
            m = gla_mixer(h, gla_w_in[i], gla_wa2_f[i], gla_ba2_f[i], gla_wa2_b[i],
                          gla_ba2_b[i], gla_gn_g[i], gla_w_out[i])
        x = x + rms_norm(m, mix_post_g[layer])
        h = rms_norm(x, ffn_pre_g[layer])
        f = swiglu_ffn(h, ffn_w_gu[layer], ffn_w_down[layer])
        x = x + rms_norm(f, ffn_post_g[layer])
    return x
```

```cpp
#include <hip/hip_runtime.h>
#include <hip/hip_cooperative_groups.h>
#include <cstdio>
#include <cstdint>
namespace cg = cooperative_groups;

#ifndef MK_ONE_LAUNCH
#define MK_ONE_LAUNCH 1
#ifndef PROBE_P
#define PROBE_P -1
#endif
#endif

#define LAS __attribute__((address_space(3)))
typedef unsigned short bf16_t;
typedef short bf16x8 __attribute__((ext_vector_type(8)));
typedef float f32x4 __attribute__((ext_vector_type(4)));
typedef float f32x16 __attribute__((ext_vector_type(16)));
typedef unsigned u32x4 __attribute__((ext_vector_type(4)));
typedef unsigned u32x2 __attribute__((ext_vector_type(2)));
typedef float f32x2 __attribute__((ext_vector_type(2)));

constexpr int SEQ = 2048, NB = 16, D = 1024, M = NB * SEQ;
constexpr int DFF = 2816;
constexpr int U0W = 1536;
constexpr int U1W = 3328;
constexpr float EPS = 1e-6f;

constexpr size_t MiB = 1u << 20;
constexpr size_t WS_CTL = 0, CTL_CNT_BYTES = 8 * 128 * 64 * 4, WS_BAR = CTL_CNT_BYTES, CTL_BYTES = CTL_CNT_BYTES + 16384;
constexpr size_t WS_XB = 52 * MiB, XB_BANK = 128 * 256 * 4 * 4;
constexpr size_t WS_SSQ = 56 * MiB;
constexpr size_t WS_W0IN = 2 * MiB, WS_W0OUT = 7 * MiB, WS_WGU0 = 9 * MiB, WS_WGU1 = 20 * MiB, WS_WDN0 = 31 * MiB, WS_WDN1 = 37 * MiB,
                 WS_W1IN = 43 * MiB, WS_W1OUT = 50 * MiB;
constexpr size_t WS_H = 64 * MiB;
constexpr size_t WS_MB = 128 * MiB;
constexpr size_t WS_OD = 64 * MiB;
constexpr size_t WS_U = 192 * MiB;
constexpr size_t WS_CAT = 400 * MiB;
constexpr size_t WS_END = 464 * MiB;

constexpr int LDS_BYTES = 147456;

typedef __bf16 bf16x2_t __attribute__((ext_vector_type(2)));
__device__ __forceinline__ unsigned cvt_pk_bf16(float lo, float hi) { const f32x2 v = {lo, hi}; return __builtin_bit_cast(unsigned, __builtin_convertvector(v, bf16x2_t)); }
__device__ __forceinline__ unsigned f2bf(float f) { unsigned u = __builtin_bit_cast(unsigned, f); return (u + 0x7fffu + ((u >> 16) & 1u)) >> 16; }
__device__ __forceinline__ float bf2f(unsigned b) { return __builtin_bit_cast(float, b << 16); }
__device__ __forceinline__ float bflo(unsigned w) { return __builtin_bit_cast(float, w << 16); }
__device__ __forceinline__ float bfhi(unsigned w) { return __builtin_bit_cast(float, w & 0xffff0000u); }
__device__ __forceinline__ float sigmoidf_(float x) { return __builtin_amdgcn_rcpf(1.0f + __expf(-x)); }
#define DPP_F(v, ctrl) __builtin_bit_cast(float, __builtin_amdgcn_update_dpp(0, __builtin_bit_cast(int, (v)), (ctrl), 0xF, 0xF, true))
__device__ __forceinline__ float row16_sum(float v) { v += DPP_F(v, 0xB1); v += DPP_F(v, 0x4E); v += DPP_F(v, 0x141); v += DPP_F(v, 0x140); return v; }
__device__ __forceinline__ float wave_sum(float v) {
    v = row16_sum(v);
    const float a = __builtin_bit_cast(float, __builtin_amdgcn_readlane(__builtin_bit_cast(int, v), 0)), b = __builtin_bit_cast(float, __builtin_amdgcn_readlane(__builtin_bit_cast(int, v), 16)),
                c = __builtin_bit_cast(float, __builtin_amdgcn_readlane(__builtin_bit_cast(int, v), 32)), d = __builtin_bit_cast(float, __builtin_amdgcn_readlane(__builtin_bit_cast(int, v), 48));
    return (a + b) + (c + d);
}

namespace pg8 {
#define PG8_LAS __attribute__((address_space(3)))
constexpr int BM = 256, BK = 64, HALF = 128, HTB = HALF * BK * 2, STAGE_BYTES = 8 * HTB, NXCD = 8, WGM = 8;
__host__ __device__ __forceinline__ int lds_byte(int r, int c) { const int st = (r >> 4) * 2 + (c >> 5), rr = r & 15, cc = c & 31, ob = rr * 64 + cc * 2; return st * 1024 + (ob ^ (((ob >> 9) & 1) << 5)); }
__host__ __device__ __forceinline__ void stage_rc(int b, int& R, int& C) { const int st = b / 1024, sb = b % 1024, swz = sb ^ (((sb >> 9) & 1) << 5); R = (st >> 1) * 16 + swz / 64; C = (st & 1) * 32 + (swz % 64) / 2; }
__host__ __device__ __forceinline__ int perm32(int rho) { const int n = rho >> 4, i = rho & 15; return 8 * (i >> 2) + 4 * n + (i & 3); }

struct Unit { int pm, pn; };
__device__ __forceinline__ int unit_pm(int i, int nM, int nN, int G, int c) {
    const int nwg = nM * nN; const long L = (long)i * G + c; if (L >= nwg) return -1;
    int wgid = (int)L; { const int q = nwg / 8, r = nwg % 8, xcd = wgid % 8, off = wgid / 8; wgid = (xcd < r ? xcd * (q + 1) : r * (q + 1) + (xcd - r) * q) + off; }
    const int nig = 8 * nN, gid = wgid / nig, fm = gid * 8, gsz = (nM - fm) < 8 ? (nM - fm) : 8;
    return fm + ((wgid % nig) % gsz);
}

struct Gemm { const bf16_t* A; const bf16_t* Bt; int M, N, K; };

struct StaticOrder {
    int nM, nN, nwg, G, c;
    __host__ __device__ void init(int M_, int N_, int G_, int c_) { nM = M_ / BM; nN = N_ / BM; nwg = nM * nN; G = G_; c = c_; }
    __host__ __device__ bool next(int i, Unit& u) const {
        const long L = (long)i * G + c; if (L >= nwg) return false;
        int wgid = (int)L; { const int q = nwg / NXCD, r = nwg % NXCD, xcd = wgid % NXCD, off = wgid / NXCD; wgid = (xcd < r ? xcd * (q + 1) : r * (q + 1) + (xcd - r) * q) + off; }
        const int nig = WGM * nN, gid = wgid / nig, fm = gid * WGM, gsz = (nM - fm) < WGM ? (nM - fm) : WGM;
        u.pm = fm + ((wgid % nig) % gsz); u.pn = (wgid % nig) / gsz; return true;
    }
    __host__ __device__ int pm_of(int i) const {
        const long L = (long)i * G + c; if (L >= nwg) return -1;
        int wgid = (int)L; { const int q = nwg / NXCD, r = nwg % NXCD, xcd = wgid % NXCD, off = wgid / NXCD; wgid = (xcd < r ? xcd * (q + 1) : r * (q + 1) + (xcd - r) * q) + off; }
        const int nig = WGM * nN, gid = wgid / nig, fm = gid * WGM, gsz = (nM - fm) < WGM ? (nM - fm) : WGM;
        return fm + ((wgid % nig) % gsz);
    }
};

struct EpiGen {
    static constexpr bool PERM = true;
    bf16_t* O; int ldc; int kind; const PG8_LAS float* rstab;
    __device__ __forceinline__ void operator()(const f32x4 (&acc)[2][2][4][2], const Unit& u, int wr, int wc, int fr, int fq, int ui) const {
        const int row0 = u.pm * BM + wr * 64 + fr;
        const PG8_LAS float* rst = rstab + ui * 256 + wr * 64 + fr;
        const int cw = wc * 32 + 8 * fq;
        int mode = 0, colbase = u.pn * BM;
        if (kind == 0) { if (u.pn < 4) { mode = 1; colbase = u.pn * 128; } else if (u.pn < 8) { mode = 2; colbase = 512 + (u.pn - 4) * 128; } else { colbase = 1024 + (u.pn - 8) * 256; } }
        else if (kind == 1) { mode = 3; colbase = u.pn * 128; }
        if (mode == 0) {
#pragma unroll
            for (int ai = 0; ai < 2; ++ai)
#pragma unroll
                for (int m = 0; m < 4; ++m) {
                    const int row = row0 + ai * HALF + m * 16;
                    bf16_t* rowp = O + (size_t)row * ldc + colbase + cw;
                    const float rs = rst[ai * HALF + m * 16];
#pragma unroll
                    for (int bj = 0; bj < 2; ++bj) { const f32x4 v0 = acc[ai][bj][m][0] * rs, v1 = acc[ai][bj][m][1] * rs;
                        u32x4 w; w.x = cvt_pk_bf16(v0[0], v0[1]); w.y = cvt_pk_bf16(v0[2], v0[3]); w.z = cvt_pk_bf16(v1[0], v1[1]); w.w = cvt_pk_bf16(v1[2], v1[3]);
                        *(u32x4*)(rowp + bj * HALF) = w; }
                }
        } else if (mode == 1) gated<1>(acc, rst, O + (size_t)row0 * ldc + colbase + cw);
        else if (mode == 2) gated<2>(acc, rst, O + (size_t)row0 * ldc + colbase + cw);
        else gated<3>(acc, rst, O + (size_t)row0 * ldc + colbase + cw);
    }
    template <int MODE> __device__ __forceinline__ void gated(const f32x4 (&acc)[2][2][4][2], const PG8_LAS float* rst, bf16_t* base) const {
#pragma unroll
        for (int ai = 0; ai < 2; ++ai)
#pragma unroll
            for (int m = 0; m < 4; ++m) {
                const float rs = rst[ai * HALF + m * 16]; const float rs2 = rs * rs, nrl = rs * -1.4426950408889634f;
                unsigned w[4];
#pragma unroll
                for (int n = 0; n < 2; ++n)
#pragma unroll
                    for (int h = 0; h < 2; ++h) {
                        const f32x2 a = {acc[ai][0][m][n][2 * h], acc[ai][0][m][n][2 * h + 1]}, b = {acc[ai][1][m][n][2 * h], acc[ai][1][m][n][2 * h + 1]};
                        f32x2 o = (a * b) * rs2;
                        if (MODE != 2) { const f32x2 t = (MODE == 1 ? b : a) * nrl; f32x2 d; d.x = __builtin_amdgcn_exp2f(t.x); d.y = __builtin_amdgcn_exp2f(t.y); d = d + 1.0f;
                            f32x2 r; r.x = __builtin_amdgcn_rcpf(d.x); r.y = __builtin_amdgcn_rcpf(d.y);
                            o = MODE == 1 ? (a * rs) * r : o * r; }
                        w[n * 2 + h] = cvt_pk_bf16(o.x, o.y);
                    }
                *(u32x4*)(base + (size_t)(ai * HALF + m * 16) * ldc) = (u32x4){w[0], w[1], w[2], w[3]};
            }
    }
};

struct OneUnit { StaticOrder so; int round;
    __device__ __forceinline__ bool next(int i, Unit& u) const { return i == 0 ? so.next(round, u) : false; } };

__device__ __forceinline__ void panel_rstd(const f32x4 (&v)[2][2][4][2], const Unit& u, int wr, int wc, int fr, int fq, PG8_LAS unsigned char* lds, int wid, int lane, float* xbuf, unsigned* cnt) {
    PG8_LAS float* P = (PG8_LAS float*)lds;
    PG8_LAS float* S = (PG8_LAS float*)(lds + 8192);
#pragma unroll
    for (int ai = 0; ai < 2; ++ai)
#pragma unroll
        for (int m = 0; m < 4; ++m) {
            float s = 0.f;
#pragma unroll
            for (int bj = 0; bj < 2; ++bj)
#pragma unroll
                for (int n = 0; n < 2; ++n) { const f32x4 x = v[ai][bj][m][n]; s += (x[0] * x[0] + x[1] * x[1]) + (x[2] * x[2] + x[3] * x[3]); }
            s += __shfl_xor(s, 16); s += __shfl_xor(s, 32);
            if (fq == 0) P[(ai * HALF + wr * 64 + m * 16 + fr) * 4 + wc] = s;
        }
    asm volatile("s_waitcnt lgkmcnt(0)" ::: "memory"); __builtin_amdgcn_s_barrier(); asm volatile("" ::: "memory");
    const int row = wid * 32 + (lane & 31);
    if (lane < 32) {
        const f32x4 p = *(const PG8_LAS f32x4*)(P + row * 4);
        const float t = (p[0] + p[1]) + (p[2] + p[3]);
        __hip_atomic_store((unsigned*)xbuf + ((size_t)(u.pm * BM + row) * 4 + u.pn), __builtin_bit_cast(unsigned, t), __ATOMIC_RELAXED, __HIP_MEMORY_SCOPE_AGENT);
    }
    asm volatile("s_waitcnt vmcnt(0)" ::: "memory");
    if (lane == 0) __hip_atomic_fetch_add(cnt + 64 * u.pm, 1u, __ATOMIC_RELAXED, __HIP_MEMORY_SCOPE_AGENT);
    if (wid == 0) {
        unsigned spins = 0;
        while ((unsigned)__builtin_amdgcn_readfirstlane(__hip_atomic_load(cnt + 64 * u.pm, __ATOMIC_RELAXED, __HIP_MEMORY_SCOPE_AGENT)) < 32u) { __builtin_amdgcn_s_sleep(2); if (++spins > (1u << 22)) break; }
        __builtin_amdgcn_fence(__ATOMIC_ACQUIRE, "agent");
    }
    asm volatile("s_waitcnt vmcnt(0) lgkmcnt(0)" ::: "memory"); __builtin_amdgcn_s_barrier(); asm volatile("" ::: "memory");
    if (lane < 32) {
        const unsigned* slot = (const unsigned*)xbuf + (size_t)(u.pm * BM + row) * 4; float tot = 0.f;
#pragma unroll
        for (int t = 0; t < 4; ++t) tot += __builtin_bit_cast(float, __hip_atomic_load(slot + t, __ATOMIC_RELAXED, __HIP_MEMORY_SCOPE_AGENT));
        S[row] = 1.0f / sqrtf(tot * (1.0f / 1024.0f) + 1e-6f);
    }
    asm volatile("s_waitcnt lgkmcnt(0)" ::: "memory"); __builtin_amdgcn_s_barrier(); asm volatile("" ::: "memory");
}

struct EpiFused {
    static constexpr bool PERM = true;
    const void* xin; void* xout; int in_bf, out_bf; const float* gpost; float* xb1; unsigned* cnt1; float* ssq;
    __device__ __forceinline__ void operator()(const f32x4 (&)[2][2][4][2], const Unit&, int, int, int, int, int) const {}
    __device__ __forceinline__ void fused(f32x4 (&acc)[2][2][4][2], const Unit& u, int wr, int wc, int fr, int fq, PG8_LAS unsigned char* lds, int wid, int lane) const {
        PG8_LAS float* P = (PG8_LAS float*)lds;
        const PG8_LAS float* S = (const PG8_LAS float*)(lds + 8192);
        const int col0 = u.pn * BM + wc * 32 + 8 * fq;
        u32x4 xw[4][2];
        if (in_bf) {
#pragma unroll
            for (int m = 0; m < 4; ++m)
#pragma unroll
                for (int bj = 0; bj < 2; ++bj) xw[m][bj] = *(const u32x4*)((const bf16_t*)xin + (size_t)(u.pm * BM + wr * 64 + m * 16 + fr) * 1024 + col0 + bj * HALF);
        }
        panel_rstd(acc, u, wr, wc, fr, fq, lds, wid, lane, xb1, cnt1);
        f32x4 g[2][2];
#pragma unroll
        for (int bj = 0; bj < 2; ++bj)
#pragma unroll
            for (int n = 0; n < 2; ++n) g[bj][n] = *(const f32x4*)(gpost + col0 + bj * HALF + 4 * n);
#pragma unroll
        for (int ai = 0; ai < 2; ++ai)
#pragma unroll
            for (int m = 0; m < 4; ++m) { const int r = ai * HALF + wr * 64 + m * 16 + fr; const float rs = S[r]; const size_t off = (size_t)(u.pm * BM + r) * 1024 + col0;
                float sq = 0.f;
#pragma unroll
                for (int bj = 0; bj < 2; ++bj) {
                    f32x4 b0, b1;
                    if (in_bf) { const u32x4 w = ai == 0 ? xw[m][bj] : *(const u32x4*)((const bf16_t*)xin + off + bj * HALF); b0 = (f32x4){bflo(w.x), bfhi(w.x), bflo(w.y), bfhi(w.y)}; b1 = (f32x4){bflo(w.z), bfhi(w.z), bflo(w.w), bfhi(w.w)}; }
                    else { b0 = *(const f32x4*)((const float*)xin + off + bj * HALF); b1 = *(const f32x4*)((const float*)xin + off + bj * HALF + 4); }
                    const f32x4 o0 = b0 + acc[ai][bj][m][0] * rs * g[bj][0], o1 = b1 + acc[ai][bj][m][1] * rs * g[bj][1];
                    sq += (o0[0] * o0[0] + o0[1] * o0[1]) + (o0[2] * o0[2] + o0[3] * o0[3]) + (o1[0] * o1[0] + o1[1] * o1[1]) + (o1[2] * o1[2] + o1[3] * o1[3]);
                    if (out_bf) { u32x4 w; w.x = cvt_pk_bf16(o0[0], o0[1]); w.y = cvt_pk_bf16(o0[2], o0[3]); w.z = cvt_pk_bf16(o1[0], o1[1]); w.w = cvt_pk_bf16(o1[2], o1[3]); *(u32x4*)((bf16_t*)xout + off + bj * HALF) = w; }
                    else { *(f32x4*)((float*)xout + off + bj * HALF) = o0; *(f32x4*)((float*)xout + off + bj * HALF + 4) = o1; } }
                sq += __shfl_xor(sq, 16); sq += __shfl_xor(sq, 32);
                if (fq == 0) P[r * 4 + wc] = sq;
                if (m & 1) asm volatile("" ::: "memory"); }
        asm volatile("s_waitcnt lgkmcnt(0)" ::: "memory"); __builtin_amdgcn_s_barrier(); asm volatile("" ::: "memory");
        if (ssq && lane < 32) { const int row = wid * 32 + lane; const f32x4 p = *(const PG8_LAS f32x4*)(P + row * 4); ssq[(size_t)(u.pm * BM + row) * 4 + u.pn] = (p[0] + p[1]) + (p[2] + p[3]); }
        asm volatile("s_waitcnt lgkmcnt(0)" ::: "memory"); __builtin_amdgcn_s_barrier(); asm volatile("" ::: "memory");
    }
};

template <class Epi, class Sched, bool ALIGN_EPI, bool SP2, bool FUSED>
__device__ __forceinline__ void gemm_phase(PG8_LAS unsigned char* lds, const Gemm g, const Sched& S, const Epi& E, const int tid) {
    const int wid = __builtin_amdgcn_readfirstlane(tid >> 6), lane = tid & 63, wr = wid >> 2, wc = wid & 3, fr = lane & 15, fq = lane >> 4;
    const int K = g.K, nt = K / BK;
    unsigned voffA[2], voffB[2];
#pragma unroll
    for (int i = 0; i < 2; ++i) { int R, C; stage_rc(tid * 16 + i * 8192, R, C); const int Rb = Epi::PERM ? ((R & ~31) + perm32(R & 31)) : R;
        voffA[i] = (unsigned)(R * K + C) * 2u; voffB[i] = (unsigned)(Rb * K + C) * 2u; }
    const size_t kstep = (size_t)(BK * 2);
    const size_t hstep = (size_t)HALF * K * 2;
    const size_t tstep = 2 * hstep;
    const unsigned ldsw = (unsigned)wid * 1024u;
    const int aoff = lds_byte(wr * 64 + fr, fq * 8), boff = lds_byte(wc * 32 + fr, fq * 8);
#define PG8_SA(b, h) (((b) * 2 + (h)) * HTB)
#define PG8_SB(b, h) ((4 + (b) * 2 + (h)) * HTB)
#define PG8_STAGE(bufoff, gbase, voff) do { _Pragma("unroll") for (int _i = 0; _i < 2; ++_i) \
        __builtin_amdgcn_global_load_lds((const unsigned*)((const char*)(gbase) + (voff)[_i]), (PG8_LAS unsigned*)(lds + (bufoff) + ldsw + _i * 8192), 16, 0, 0); } while (0)
#define PG8_LDA(dst, b, h) do { _Pragma("unroll") for (int m = 0; m < 4; ++m) _Pragma("unroll") for (int k = 0; k < 2; ++k) dst[m][k] = *(const PG8_LAS bf16x8*)(lds + PG8_SA(b, h) + aoff + m * 2048 + k * 1024); } while (0)
#define PG8_LDB(dst, b, h) do { _Pragma("unroll") for (int n = 0; n < 2; ++n) _Pragma("unroll") for (int k = 0; k < 2; ++k) dst[n][k] = *(const PG8_LAS bf16x8*)(lds + PG8_SB(b, h) + boff + n * 2048 + k * 1024); } while (0)
#define PG8_MMA(ai, bj, At, Bt) do { __builtin_amdgcn_s_setprio(1); _Pragma("unroll") for (int m = 0; m < 4; ++m) _Pragma("unroll") for (int n = 0; n < 2; ++n) _Pragma("unroll") for (int k = 0; k < 2; ++k) \
        acc[ai][bj][m][n] = __builtin_amdgcn_mfma_f32_16x16x32_bf16(Bt[n][k], At[m][k], acc[ai][bj][m][n], 0, 0, 0); __builtin_amdgcn_s_setprio(0); } while (0)
#define PG8_WAIT_V(n) asm volatile("s_waitcnt vmcnt(" #n ")" ::: "memory")
#define PG8_WAIT_L(n) asm volatile("s_waitcnt lgkmcnt(" #n ")" ::: "memory")
#define PG8_BAR __builtin_amdgcn_s_barrier()
#define PG8_SCHED __builtin_amdgcn_sched_barrier(0)
    Unit cur, nxt; int ui = 0;
    if (!S.next(0, cur)) return;
    f32x4 acc[2][2][4][2];
#pragma unroll
    for (int a = 0; a < 2; ++a)
#pragma unroll
        for (int b = 0; b < 2; ++b)
#pragma unroll
            for (int m = 0; m < 4; ++m)
#pragma unroll
                for (int n = 0; n < 2; ++n) acc[a][b][m][n] = (f32x4){0.f, 0.f, 0.f, 0.f};
    bf16x8 At[4][2], B0[2][2], B1[2][2];
    const char* cA = (const char*)g.A + (size_t)cur.pm * tstep; const char* cB = (const char*)g.Bt + (size_t)cur.pn * tstep;
    if constexpr (SP2) {
        PG8_STAGE(PG8_SB(0, 0), cB, voffB); PG8_STAGE(PG8_SB(0, 1), cB + hstep, voffB); PG8_STAGE(PG8_SA(0, 0), cA, voffA); PG8_STAGE(PG8_SA(0, 1), cA + hstep, voffA);
        if (wr == 1) PG8_BAR;
        PG8_WAIT_V(2); PG8_BAR;
        PG8_STAGE(PG8_SB(1, 0), cB + kstep, voffB); PG8_STAGE(PG8_SA(1, 0), cA + kstep, voffA); PG8_STAGE(PG8_SB(1, 1), cB + hstep + kstep, voffB);
        PG8_WAIT_V(6); PG8_BAR;
    } else {
        PG8_STAGE(PG8_SB(0, 0), cB, voffB); PG8_STAGE(PG8_SA(0, 0), cA, voffA); PG8_STAGE(PG8_SB(0, 1), cB + hstep, voffB); PG8_STAGE(PG8_SA(0, 1), cA + hstep, voffA);
        if (wr == 1) PG8_BAR;
        PG8_WAIT_V(4); PG8_BAR;
        PG8_STAGE(PG8_SB(1, 0), cB + kstep, voffB); PG8_STAGE(PG8_SA(1, 0), cA + kstep, voffA); PG8_STAGE(PG8_SB(1, 1), cB + hstep + kstep, voffB);
        PG8_WAIT_V(6); PG8_BAR;
    }
    for (;;) {
        const bool has_next = S.next(ui + 1, nxt);
        const char* nA = has_next ? (const char*)g.A + (size_t)nxt.pm * tstep : cA; const char* nB = has_next ? (const char*)g.Bt + (size_t)nxt.pn * tstep : cB;
        for (int t = 0; t < nt; t += 2) {
            const bool last = (t == nt - 2);
            const char* a1 = cA + (size_t)(t + 1) * kstep;
            const char* a2 = last ? nA : cA + (size_t)(t + 2) * kstep; const char* b2 = last ? nB : cB + (size_t)(t + 2) * kstep;
            const char* a3 = a2 + kstep; const char* b3 = b2 + kstep;
            if constexpr (SP2) {
            PG8_LDB(B0, 0, 0); PG8_LDB(B1, 0, 1); PG8_SCHED; PG8_LDA(At, 0, 0); PG8_STAGE(PG8_SA(1, 1), a1 + hstep, voffA);
            PG8_WAIT_V(8); PG8_WAIT_L(0); PG8_BAR; PG8_MMA(0, 0, At, B0); PG8_MMA(0, 1, At, B1); PG8_BAR; PG8_SCHED;
            PG8_LDA(At, 0, 1); PG8_STAGE(PG8_SB(0, 0), b2, voffB); PG8_STAGE(PG8_SB(0, 1), b2 + hstep, voffB); PG8_STAGE(PG8_SA(0, 0), a2, voffA);
            PG8_WAIT_V(8); PG8_WAIT_L(0); PG8_BAR; PG8_MMA(1, 0, At, B0); PG8_MMA(1, 1, At, B1); PG8_BAR; PG8_SCHED;
            PG8_LDB(B0, 1, 0); PG8_LDB(B1, 1, 1); PG8_SCHED; PG8_LDA(At, 1, 0); PG8_STAGE(PG8_SA(0, 1), a2 + hstep, voffA);
            PG8_WAIT_V(8); PG8_WAIT_L(0); PG8_BAR; PG8_MMA(0, 0, At, B0); PG8_MMA(0, 1, At, B1); PG8_BAR; PG8_SCHED;
            PG8_LDA(At, 1, 1); PG8_STAGE(PG8_SB(1, 0), b3, voffB); PG8_STAGE(PG8_SB(1, 1), b3 + hstep, voffB); PG8_STAGE(PG8_SA(1, 0), a3, voffA);
            PG8_WAIT_V(8); PG8_WAIT_L(0); PG8_BAR; PG8_MMA(1, 0, At, B0); PG8_MMA(1, 1, At, B1); PG8_BAR; PG8_SCHED;
            } else {
            PG8_LDB(B0, 0, 0); PG8_SCHED; PG8_LDA(At, 0, 0); PG8_STAGE(PG8_SA(1, 1), a1 + hstep, voffA);
            PG8_WAIT_L(8); PG8_BAR; PG8_WAIT_L(0); PG8_MMA(0, 0, At, B0); PG8_BAR; PG8_SCHED;
            PG8_LDB(B1, 0, 1); PG8_STAGE(PG8_SB(0, 0), b2, voffB);
            PG8_BAR; PG8_WAIT_L(0); PG8_MMA(0, 1, At, B1); PG8_BAR;
            PG8_LDA(At, 0, 1); PG8_STAGE(PG8_SA(0, 0), a2, voffA);
            PG8_BAR; PG8_WAIT_L(0); PG8_MMA(1, 0, At, B0); PG8_BAR; PG8_SCHED;
            PG8_STAGE(PG8_SB(0, 1), b2 + hstep, voffB);
            PG8_WAIT_V(6); PG8_BAR; PG8_MMA(1, 1, At, B1); PG8_BAR;
            PG8_LDB(B0, 1, 0); PG8_SCHED; PG8_LDA(At, 1, 0); PG8_STAGE(PG8_SA(0, 1), a2 + hstep, voffA);
            PG8_WAIT_L(8); PG8_BAR; PG8_WAIT_L(0); PG8_MMA(0, 0, At, B0); PG8_BAR; PG8_SCHED;
            PG8_LDB(B1, 1, 1); PG8_STAGE(PG8_SB(1, 0), b3, voffB);
            PG8_BAR; PG8_WAIT_L(0); PG8_MMA(0, 1, At, B1); PG8_BAR;
            PG8_LDA(At, 1, 1); PG8_STAGE(PG8_SA(1, 0), a3, voffA);
            PG8_BAR; PG8_WAIT_L(0); PG8_MMA(1, 0, At, B0); PG8_BAR; PG8_SCHED;
            PG8_STAGE(PG8_SB(1, 1), b3 + hstep, voffB);
            PG8_WAIT_V(6); PG8_BAR; PG8_MMA(1, 1, At, B1); PG8_BAR;
            }
        }
        if constexpr (ALIGN_EPI) { if (wr == 0) PG8_BAR; }
        if constexpr (!FUSED) E(acc, cur, wr, wc, fr, fq, ui);
        if (!has_next) break;
#pragma unroll
        for (int a = 0; a < 2; ++a)
#pragma unroll
            for (int b = 0; b < 2; ++b)
#pragma unroll
                for (int m = 0; m < 4; ++m)
#pragma unroll
                    for (int n = 0; n < 2; ++n) acc[a][b][m][n] = (f32x4){0.f, 0.f, 0.f, 0.f};
        cur = nxt; cA = nA; cB = nB; ++ui;
        if constexpr (ALIGN_EPI) { if (wr == 1) PG8_BAR; }
    }
    PG8_WAIT_V(0);
    if constexpr (!ALIGN_EPI) { if (wr == 0) PG8_BAR; }
    PG8_BAR;
    if constexpr (FUSED) E.fused(acc, cur, wr, wc, fr, fq, lds, wid, lane);
#undef PG8_SA
#undef PG8_SB
#undef PG8_STAGE
#undef PG8_LDA
#undef PG8_LDB
#undef PG8_MMA
#undef PG8_WAIT_V
#undef PG8_WAIT_L
#undef PG8_BAR
#undef PG8_SCHED
}
}

__device__ __forceinline__ int srccol(int kind, int n0, int nsrc) {
    if (kind == 0) { const int t = n0 >> 8, w = n0 & 255, bj = w >> 7, j = w & 127;
        if (t < 4) return bj == 0 ? 128 * t + j : 512 + 128 * t + j;
        if (t < 8) return bj == 0 ? 1536 + 128 * (t - 4) + j : 2048 + 128 * (t - 4) + j;
        return 1024 + 256 * (t - 8) + w; }
    if (kind == 1) { const int pn = n0 >> 8, w = n0 & 255, bj = w >> 7, j = w & 127; return bj * DFF + 128 * pn + j; }
    return n0 < nsrc ? n0 : -1;
}
__device__ __forceinline__ void p0_transpose_item(const float* W, const float* gk, int K, int N, bf16_t* WT, int kind, LAS float* scr, int item, int ndst, int lane) {
    const int nblk = ndst / 32, kb = item / nblk, nb = item % nblk, k0 = 64 * kb, n0 = 32 * nb;
    const int sc = srccol(kind, n0, N);
    const float wsc = (kind == 3 && n0 < 512) ? 0.08838834764831845f : 1.0f;
    float tmp[32];
#pragma unroll
    for (int i = 0; i < 32; ++i) { const int kk = 2 * i + (lane >> 5); tmp[i] = sc >= 0 ? W[(size_t)(k0 + kk) * N + sc + (lane & 31)] * (gk ? gk[k0 + kk] * wsc : wsc) : 0.f; }
#pragma unroll
    for (int i = 0; i < 32; ++i) { const int kk = 2 * i + (lane >> 5); scr[kk * 33 + (lane & 31)] = tmp[i]; }
    asm volatile("s_waitcnt lgkmcnt(0)" ::: "memory");
    const int c = lane & 7;
#pragma unroll
    for (int j = 0; j < 4; ++j) { const int n = (lane >> 3) + 8 * j; const LAS float* s = scr + (8 * c) * 33 + n;
        u32x4 o; o.x = cvt_pk_bf16(s[0 * 33], s[1 * 33]); o.y = cvt_pk_bf16(s[2 * 33], s[3 * 33]); o.z = cvt_pk_bf16(s[4 * 33], s[5 * 33]); o.w = cvt_pk_bf16(s[6 * 33], s[7 * 33]);
        *(u32x4*)(WT + (size_t)(n0 + n) * K + k0 + 8 * c) = o; }
    asm volatile("s_waitcnt lgkmcnt(0)" ::: "memory");
}

__device__ __forceinline__ void norm_phase(const float* xin, const bf16_t* mb, const float* ss, const float* gpost, const float* gpre, float* xout, bf16_t* h, int gw, int ngw, int lane) {
    for (int row0 = gw; row0 < M; row0 += 2 * ngw) {
        const bool two = row0 + ngw < M;
        f32x4 v[2][4]; u32x2 mw[2][4]; float sv[2];
#pragma unroll
        for (int r = 0; r < 2; ++r) { if (r == 1 && !two) break; const int row = row0 + r * ngw;
            const f32x4* xr = (const f32x4*)(xin + (size_t)row * D) + lane;
#pragma unroll
            for (int j = 0; j < 4; ++j) v[r][j] = xr[64 * j];
            if (mb) { sv[r] = ss[(size_t)row * 16 + (lane & 15)]; const u32x2* mr = (const u32x2*)(mb + (size_t)row * D) + lane;
#pragma unroll
                for (int j = 0; j < 4; ++j) mw[r][j] = mr[64 * j]; } }
#pragma unroll
        for (int r = 0; r < 2; ++r) { if (r == 1 && !two) break; const int row = row0 + r * ngw;
            if (mb) {
                const float rs = 1.0f / sqrtf(row16_sum(sv[r]) * (1.0f / D) + EPS);
#pragma unroll
                for (int j = 0; j < 4; ++j) { const u32x2 w = mw[r][j]; const f32x4 g = ((const f32x4*)gpost)[64 * j + lane];
                    v[r][j][0] += bflo(w.x) * rs * g[0]; v[r][j][1] += bfhi(w.x) * rs * g[1]; v[r][j][2] += bflo(w.y) * rs * g[2]; v[r][j][3] += bfhi(w.y) * rs * g[3]; }
            }
            if (xout) { f32x4* xo = (f32x4*)(xout + (size_t)row * D) + lane;
#pragma unroll
                for (int j = 0; j < 4; ++j) xo[64 * j] = v[r][j]; }
            if (h) {
                float s2 = 0.f;
#pragma unroll
                for (int j = 0; j < 4; ++j) s2 += (v[r][j][0] * v[r][j][0] + v[r][j][1] * v[r][j][1]) + (v[r][j][2] * v[r][j][2] + v[r][j][3] * v[r][j][3]);
                const float rs = 1.0f / sqrtf(wave_sum(s2) * (1.0f / D) + EPS);
                u32x2* ho = (u32x2*)(h + (size_t)row * D) + lane;
#pragma unroll
                for (int j = 0; j < 4; ++j) { const f32x4 g = ((const f32x4*)gpre)[64 * j + lane]; u32x2 w; w.x = cvt_pk_bf16(v[r][j][0] * rs * g[0], v[r][j][1] * rs * g[1]); w.y = cvt_pk_bf16(v[r][j][2] * rs * g[2], v[r][j][3] * rs * g[3]); ho[64 * j] = w; }
            }
        }
    }
}

__device__ __forceinline__ void cvt_phase(const float* xin, bf16_t* xb, float* ssq, int gw, int ngw, int lane) {
    constexpr int R = 4;
    for (int row0 = gw; row0 < M; row0 += R * ngw) {
        f32x4 v[R][4];
#pragma unroll
        for (int r = 0; r < R; ++r) { if (row0 + r * ngw >= M) break; const f32x4* xr = (const f32x4*)(xin + (size_t)(row0 + r * ngw) * D) + lane;
#pragma unroll
            for (int j = 0; j < 4; ++j) v[r][j] = __builtin_nontemporal_load(xr + 64 * j); }
#pragma unroll
        for (int r = 0; r < R; ++r) { const int row = row0 + r * ngw; if (row >= M) break;
            float s2 = 0.f; u32x2* ho = (u32x2*)(xb + (size_t)row * D) + lane;
#pragma unroll
            for (int j = 0; j < 4; ++j) { s2 += (v[r][j][0] * v[r][j][0] + v[r][j][1] * v[r][j][1]) + (v[r][j][2] * v[r][j][2] + v[r][j][3] * v[r][j][3]);
                u32x2 w; w.x = cvt_pk_bf16(v[r][j][0], v[r][j][1]); w.y = cvt_pk_bf16(v[r][j][2], v[r][j][3]); ho[64 * j] = w; }
            s2 = wave_sum(s2);
            if (lane == 0) *(f32x4*)(ssq + (size_t)row * 4) = (f32x4){s2, 0.f, 0.f, 0.f};
        }
    }
}

__device__ __forceinline__ void gla_combine_phase(const bf16_t* od, const bf16_t* u1, const float* gn, bf16_t* og, int gw, int ngw, int lane) {
    for (int row0 = gw; row0 < M; row0 += 2 * ngw) {
        const bool two = row0 + ngw < M;
        u32x2 wa[2][4], wb[2][4], wr_[2][4];
#pragma unroll
        for (int r = 0; r < 2; ++r) { if (r == 1 && !two) break; const int row = row0 + r * ngw;
            const u32x2* a = (const u32x2*)(od + (size_t)row * D) + lane;
            const u32x2* b = (const u32x2*)(od + (size_t)M * D + (size_t)row * D) + lane;
            const u32x2* rr = (const u32x2*)(u1 + (size_t)row * U1W + 2048) + lane;
#pragma unroll
            for (int j = 0; j < 4; ++j) { wa[r][j] = a[64 * j]; wb[r][j] = b[64 * j]; wr_[r][j] = rr[64 * j]; } }
#pragma unroll
        for (int r = 0; r < 2; ++r) { if (r == 1 && !two) break; const int row = row0 + r * ngw;
            u32x2* o = (u32x2*)(og + (size_t)row * D) + lane;
#pragma unroll
            for (int j = 0; j < 4; ++j) {
                const f32x4 g = ((const f32x4*)gn)[64 * j + lane];
                float v0 = bflo(wa[r][j].x) + bflo(wb[r][j].x), v1 = bfhi(wa[r][j].x) + bfhi(wb[r][j].x), v2 = bflo(wa[r][j].y) + bflo(wb[r][j].y), v3 = bfhi(wa[r][j].y) + bfhi(wb[r][j].y);
                const float s = wave_sum((v0 * v0 + v1 * v1) + (v2 * v2 + v3 * v3));
                const float rs = 1.0f / sqrtf(s * (1.0f / 256.0f) + EPS);
                const float r0 = bflo(wr_[r][j].x), r1 = bfhi(wr_[r][j].x), r2 = bflo(wr_[r][j].y), r3 = bfhi(wr_[r][j].y);
                v0 = v0 * rs * g[0] * (r0 * sigmoidf_(r0)); v1 = v1 * rs * g[1] * (r1 * sigmoidf_(r1)); v2 = v2 * rs * g[2] * (r2 * sigmoidf_(r2)); v3 = v3 * rs * g[3] * (r3 * sigmoidf_(r3));
                u32x2 w; w.x = cvt_pk_bf16(v0, v1); w.y = cvt_pk_bf16(v2, v3); o[64 * j] = w;
            }
        }
    }
}

constexpr int CT = 32;
constexpr int CV_IN_ROWS = CT + 30;
constexpr int CV_OUT_OFF = CV_IN_ROWS * 1024;
__device__ __forceinline__ void conv_phase(LAS unsigned char* lds, const bf16_t* U0, const float* dw_w, const float* dw_b, const float* ln_g, const float* ln_b, const float* sc_w, bf16_t* CAT, int G, const int tid) {
    const int wid = tid >> 6, lane = tid & 63;
    const int p = tid & 255, th = tid >> 8;
    f32x2 w2[31];
#pragma unroll
    for (int k = 0; k < 31; ++k) w2[k] = *(const f32x2*)(dw_w + k * 512 + 2 * p);
    const f32x2 bias = *(const f32x2*)(dw_b + 2 * p);
    LAS float* OUT = (LAS float*)(lds + CV_OUT_OFF);
    for (int item = blockIdx.x; item < M / CT; item += G) {
        const int tok0 = item * CT, s0 = tok0 % SEQ, bbase = tok0 - s0;
        {
            u32x4 sv[8];
#pragma unroll
            for (int e = 0; e < 8; ++e) { const int c = tid + 512 * e, r = c >> 6, ch = c & 63; const int s = s0 - 15 + r;
                sv[e] = (u32x4){0u, 0u, 0u, 0u};
                if (c < CV_IN_ROWS * 64 && s >= 0 && s < SEQ) sv[e] = *(const u32x4*)(U0 + (size_t)(bbase + s) * U0W + ch * 8); }
#pragma unroll
            for (int e = 0; e < 8; ++e) { const int c = tid + 512 * e, r = c >> 6, ch = c & 63;
                if (c < CV_IN_ROWS * 64) *(LAS u32x4*)(lds + r * 1024 + ch * 16) = sv[e]; }
        }
        __syncthreads();
        {
            f32x2 a2[16];
#pragma unroll
            for (int i = 0; i < 16; ++i) a2[i] = bias;
#pragma unroll
            for (int jr = 0; jr < 46; ++jr) {
                const unsigned w = *(const LAS unsigned*)(lds + (16 * th + jr) * 1024 + p * 4);
                const f32x2 x2 = {bflo(w), bfhi(w)};
#pragma unroll
                for (int i = 0; i < 16; ++i) { const int kk = jr - i; if (kk >= 0 && kk <= 30) a2[i] = __builtin_elementwise_fma(w2[kk], x2, a2[i]); }
            }
#pragma unroll
            for (int i = 0; i < 16; ++i) *(LAS f32x2*)(OUT + (16 * th + i) * 512 + 2 * p) = a2[i];
        }
        __syncthreads();
        for (int t = wid; t < CT; t += 8) {
            f32x4 a = *(const LAS f32x4*)(OUT + t * 512 + 4 * lane), b = *(const LAS f32x4*)(OUT + t * 512 + 256 + 4 * lane);
            const float mean = wave_sum((a[0] + a[1]) + (a[2] + a[3]) + (b[0] + b[1]) + (b[2] + b[3])) * (1.0f / 512.0f);
            a = a - mean; b = b - mean;
            const float var = wave_sum((a[0] * a[0] + a[1] * a[1]) + (a[2] * a[2] + a[3] * a[3]) + (b[0] * b[0] + b[1] * b[1]) + (b[2] * b[2] + b[3] * b[3])) * (1.0f / 512.0f);
            const float rs = 1.0f / sqrtf(var + EPS);
            const f32x4 ga = *(const f32x4*)(ln_g + 4 * lane), gb = *(const f32x4*)(ln_g + 256 + 4 * lane), ba = *(const f32x4*)(ln_b + 4 * lane), bb = *(const f32x4*)(ln_b + 256 + 4 * lane);
            float ya[4], yb[4];
#pragma unroll
            for (int j = 0; j < 4; ++j) { const float y = a[j] * rs * ga[j] + ba[j]; ya[j] = y * sigmoidf_(y); const float z = b[j] * rs * gb[j] + bb[j]; yb[j] = z * sigmoidf_(z); }
            bf16_t* orow = CAT + (size_t)(tok0 + t) * D;
            u32x2 wa; wa.x = cvt_pk_bf16(ya[0], ya[1]); wa.y = cvt_pk_bf16(ya[2], ya[3]); *(u32x2*)(orow + 4 * lane) = wa;
            u32x2 wb; wb.x = cvt_pk_bf16(yb[0], yb[1]); wb.y = cvt_pk_bf16(yb[2], yb[3]); *(u32x2*)(orow + 256 + 4 * lane) = wb;
        }
#pragma unroll
        for (int c = tid; c < CT * 64; c += 512) { const int t = c >> 6, ch = (c & 63) * 8; const int s = s0 + t; const size_t row = (size_t)(tok0 + t);
            const bf16_t* cvp = U0 + row * U0W + 512 + ch;
            const u32x4 c0 = *(const u32x4*)cvp;
            u32x4 cm = (u32x4){0u, 0u, 0u, 0u}, cp = (u32x4){0u, 0u, 0u, 0u};
            if (s > 0) cm = *(const u32x4*)(cvp - U0W);
            if (s < SEQ - 1) cp = *(const u32x4*)(cvp + U0W);
            const u32x4 bg = *(const u32x4*)(U0 + row * U0W + 1024 + ch);
            float r[8];
#pragma unroll
            for (int q = 0; q < 4; ++q) {
                const float wm0 = sc_w[ch + 2 * q], wm1 = sc_w[ch + 2 * q + 1], wc0 = sc_w[512 + ch + 2 * q], wc1 = sc_w[512 + ch + 2 * q + 1], wp0 = sc_w[1024 + ch + 2 * q], wp1 = sc_w[1024 + ch + 2 * q + 1];
                r[2 * q] = bflo(bg[q]) * (wm0 * bflo(cm[q]) + wc0 * bflo(c0[q]) + wp0 * bflo(cp[q]));
                r[2 * q + 1] = bfhi(bg[q]) * (wm1 * bfhi(cm[q]) + wc1 * bfhi(c0[q]) + wp1 * bfhi(cp[q]));
            }
            u32x4 o; o.x = cvt_pk_bf16(r[0], r[1]); o.y = cvt_pk_bf16(r[2], r[3]); o.z = cvt_pk_bf16(r[4], r[5]); o.w = cvt_pk_bf16(r[6], r[7]);
            *(u32x4*)(CAT + row * D + 512 + ch) = o; }
    }
    __syncthreads();
}

constexpr int GL_QB = 0, GL_KB = 17408, GL_KET = 34816, GL_VT = 53248, GL_LA = 34816, GL_SC = 71680, GL_ST = 80896, GL_DEC = 115712, GL_GT = 116224;
#define MFMA16(a, b, c) __builtin_amdgcn_mfma_f32_16x16x32_bf16((a), (b), (c), 0, 0, 0)
__device__ __forceinline__ void gla_phase(LAS unsigned char* lds, const bf16_t* U, const float* wa2f, const float* ba2f, const float* wa2b, const float* ba2b, bf16_t* OD, int G, const int tid) {
    const int wid = __builtin_amdgcn_readfirstlane(tid >> 6), lane = tid & 63;
    const int l15 = lane & 15, l4 = lane >> 4;
    const float L2E = 1.4426950408889634f;
    for (int cid = blockIdx.x; cid < 256; cid += G) {
        const int vs = cid & 1, dir = (cid >> 1) & 1, h = (cid >> 2) & 3, b = cid >> 4;
        const float* wa2 = dir ? wa2b : wa2f; const float* ba2 = dir ? ba2b : ba2f;
        const int tr = wid >> 2, tc = wid & 3;
        bf16x8 wb;
#pragma unroll
        for (int j = 0; j < 8; ++j) wb[j] = (short)f2bf(wa2[(8 * (lane >> 5) + j) * 512 + h * 128 + 32 * tc + (lane & 31)]);
        const float zb = ba2[h * 128 + 32 * tc + (lane & 31)];
        f32x4 S[8];
#pragma unroll
        for (int i = 0; i < 8; ++i) S[i] = (f32x4){0.f, 0.f, 0.f, 0.f};
        for (int c = tid; c < 34816 / 16; c += 512) *(LAS u32x4*)(lds + GL_ST + c * 16) = (u32x4){0u, 0u, 0u, 0u};
        __syncthreads();
        bf16_t* od = OD + (size_t)dir * M * D;
        const size_t offg = (size_t)(32 * tr + (lane & 31)) * U1W + 3072 + dir * 16 + 8 * (lane >> 5);
        size_t offq[2];
#pragma unroll
        for (int e = 0; e < 2; ++e) { const int c = tid + 512 * e, t = c >> 4, kc = c & 15; offq[e] = (size_t)t * U1W + h * 128 + kc * 8; }
        size_t offv[2];
#pragma unroll
        for (int e = 0; e < 2; ++e) { const int c = tid + 512 * e, t = c & 63, vc = c >> 6; offv[e] = (size_t)t * U1W + 1024 + h * 256 + vs * 128 + vc * 8; }
        bf16x8 ga; u32x4 qreg[2], kreg[2], vreg[2];
        {
            const int n = dir ? 31 : 0; const bf16_t* base = U + ((size_t)b * SEQ + (size_t)n * 64) * U1W;
            ga = *(const bf16x8*)(base + offg);
#pragma unroll
            for (int e = 0; e < 2; ++e) { qreg[e] = *(const u32x4*)(base + offq[e]); kreg[e] = *(const u32x4*)(base + offq[e] + 512); vreg[e] = *(const u32x4*)(base + offv[e]); }
        }
        for (int step = 0; step < 32; ++step) {
            const int n = dir ? 31 - step : step; const size_t tok0 = (size_t)b * SEQ + (size_t)n * 64;
            u32x4 vcur[2];
            {
                f32x16 z;
#pragma unroll
                for (int i = 0; i < 16; ++i) z[i] = 0.f;
                z = __builtin_amdgcn_mfma_f32_32x32x16_bf16(ga, wb, z, 0, 0, 0);
#pragma unroll
                for (int e = 0; e < 2; ++e) { const int c = tid + 512 * e, t = c >> 4, kc = c & 15;
                    *(LAS u32x4*)(lds + GL_QB + t * 272 + kc * 16) = qreg[e]; *(LAS u32x4*)(lds + GL_KB + t * 272 + kc * 16) = kreg[e]; vcur[e] = vreg[e]; }
                const float nzb = zb * -L2E;
#pragma unroll
                for (int i = 0; i < 16; i += 2) {
                    f32x2 t = {z[i], z[i + 1]}; t = __builtin_elementwise_min(t * -L2E + nzb, (f32x2){126.f, 126.f});
                    f32x2 d; d.x = __builtin_amdgcn_exp2f(t.x); d.y = __builtin_amdgcn_exp2f(t.y); d = d + 1.0f;
                    f32x2 l; l.x = __builtin_amdgcn_logf(d.x); l.y = __builtin_amdgcn_logf(d.y); l = l * (-1.0f / 16.0f);
                    const int row = (i & 3) + 8 * (i >> 2) + 4 * (lane >> 5);
                    *(LAS float*)(lds + GL_LA + ((32 * tr + row) * 128 + 32 * tc + (lane & 31)) * 4) = l.x;
                    *(LAS float*)(lds + GL_LA + ((32 * tr + row + 1) * 128 + 32 * tc + (lane & 31)) * 4) = l.y; }
            }
            __syncthreads();
            const int kp = lane, tg = wid;
            f32x2 pc[8];
#pragma unroll
            for (int i = 0; i < 8; ++i) pc[i] = *(const LAS f32x2*)(lds + GL_LA + ((8 * tg + i) * 128 + 2 * kp) * 4);
            if (dir == 0) {
#pragma unroll
                for (int i = 1; i < 8; ++i) pc[i] += pc[i - 1];
                *(LAS f32x2*)(lds + GL_GT + (tg * 128 + 2 * kp) * 4) = pc[7];
            } else {
#pragma unroll
                for (int i = 6; i >= 0; --i) pc[i] += pc[i + 1];
                *(LAS f32x2*)(lds + GL_GT + (tg * 128 + 2 * kp) * 4) = pc[0];
            }
            __syncthreads();
            {
                const int sn = step < 31 ? step + 1 : step; const int nn = dir ? 31 - sn : sn; const bf16_t* base = U + ((size_t)b * SEQ + (size_t)nn * 64) * U1W;
                ga = *(const bf16x8*)(base + offg);
#pragma unroll
                for (int e = 0; e < 2; ++e) { qreg[e] = *(const u32x4*)(base + offq[e]); kreg[e] = *(const u32x4*)(base + offq[e] + 512); vreg[e] = *(const u32x4*)(base + offv[e]); }
            }
            {
                f32x2 tot = (f32x2){0.f, 0.f}, off = (f32x2){0.f, 0.f};
#pragma unroll
                for (int t = 0; t < 8; ++t) { const f32x2 g = *(const LAS f32x2*)(lds + GL_GT + (t * 128 + 2 * kp) * 4); tot += g; const bool take = dir == 0 ? (t < tg) : (t > tg); if (take) off += g; }
                f32x2 et; et.x = __builtin_amdgcn_exp2f(tot[0]); et.y = __builtin_amdgcn_exp2f(tot[1]);
                const float et0 = et.x, et1 = et.y;
                float ke0[8], ke1[8];
#pragma unroll
                for (int i = 0; i < 8; ++i) {
                    const f32x2 c = pc[i] + off;
                    f32x2 E, iE; E.x = __builtin_amdgcn_exp2f(c.x); E.y = __builtin_amdgcn_exp2f(c.y); iE.x = __builtin_amdgcn_rcpf(E.x); iE.y = __builtin_amdgcn_rcpf(E.y);
                    LAS unsigned* qp = (LAS unsigned*)(lds + GL_QB + (8 * tg + i) * 272 + kp * 4);
                    LAS unsigned* kq = (LAS unsigned*)(lds + GL_KB + (8 * tg + i) * 272 + kp * 4);
                    const unsigned qw = *qp, kw = *kq;
                    const f32x2 qt = (f32x2){bflo(qw), bfhi(qw)} * E, kt = (f32x2){bflo(kw), bfhi(kw)} * iE, ke = kt * et;
                    *qp = cvt_pk_bf16(qt.x, qt.y);
                    *kq = cvt_pk_bf16(kt.x, kt.y);
                    ke0[i] = ke.x; ke1[i] = ke.y;
                }
                *(LAS u32x4*)(lds + GL_KET + (2 * kp) * 144 + tg * 16) = (u32x4){cvt_pk_bf16(ke0[0], ke0[1]), cvt_pk_bf16(ke0[2], ke0[3]), cvt_pk_bf16(ke0[4], ke0[5]), cvt_pk_bf16(ke0[6], ke0[7])};
                *(LAS u32x4*)(lds + GL_KET + (2 * kp + 1) * 144 + tg * 16) = (u32x4){cvt_pk_bf16(ke1[0], ke1[1]), cvt_pk_bf16(ke1[2], ke1[3]), cvt_pk_bf16(ke1[4], ke1[5]), cvt_pk_bf16(ke1[6], ke1[7])};
                if (tg == 0) *(LAS f32x2*)(lds + GL_DEC + 2 * kp * 4) = (f32x2){et0, et1};
#pragma unroll
                for (int e = 0; e < 2; ++e) { const int c = tid + 512 * e, t = c & 63, vc = c >> 6;
#pragma unroll
                    for (int x = 0; x < 4; ++x) { const unsigned w = vcur[e][x];
                        *(LAS bf16_t*)(lds + GL_VT + (vc * 8 + 2 * x) * 144 + t * 2) = (bf16_t)(w & 0xffffu);
                        *(LAS bf16_t*)(lds + GL_VT + (vc * 8 + 2 * x + 1) * 144 + t * 2) = (bf16_t)(w >> 16); } }
            }
            __syncthreads();
            f32x4 oT[4];
            {
                bf16x8 fa[2][4], fb[2][4];
#pragma unroll
                for (int e = 0; e < 2; ++e) { const int t = 2 * wid + e, tj = t >> 2, ti = t & 3;
#pragma unroll
                    for (int kk = 0; kk < 4; ++kk) {
                        fa[e][kk] = *(const LAS bf16x8*)(lds + GL_KB + (16 * tj + l15) * 272 + (32 * kk + 8 * l4) * 2);
                        fb[e][kk] = *(const LAS bf16x8*)(lds + GL_QB + (16 * ti + l15) * 272 + (32 * kk + 8 * l4) * 2); } }
                __builtin_amdgcn_sched_barrier(0);
#pragma unroll
                for (int e = 0; e < 2; ++e) { const int t = 2 * wid + e, tj = t >> 2, ti = t & 3;
                    f32x4 sc = (f32x4){0.f, 0.f, 0.f, 0.f};
#pragma unroll
                    for (int kk = 0; kk < 4; ++kk) sc = MFMA16(fa[e][kk], fb[e][kk], sc);
                    const int i = 16 * ti + l15, j0 = 16 * tj + 4 * l4;
                    float m[4];
#pragma unroll
                    for (int x = 0; x < 4; ++x) { const int j = j0 + x; const bool keep = dir == 0 ? (j <= i) : (j >= i); m[x] = keep ? sc[x] : 0.f; }
                    u32x2 w; w.x = cvt_pk_bf16(m[0], m[1]); w.y = cvt_pk_bf16(m[2], m[3]);
                    *(LAS u32x2*)(lds + GL_SC + i * 144 + j0 * 2) = w; }
                bf16x8 sa[4], bq[4][4];
#pragma unroll
                for (int kk = 0; kk < 4; ++kk) sa[kk] = *(const LAS bf16x8*)(lds + GL_ST + (16 * wid + l15) * 272 + (32 * kk + 8 * l4) * 2);
#pragma unroll
                for (int ti = 0; ti < 4; ++ti)
#pragma unroll
                    for (int kk = 0; kk < 4; ++kk) bq[ti][kk] = *(const LAS bf16x8*)(lds + GL_QB + (16 * ti + l15) * 272 + (32 * kk + 8 * l4) * 2);
                __builtin_amdgcn_sched_barrier(0);
#pragma unroll
                for (int ti = 0; ti < 4; ++ti) { oT[ti] = (f32x4){0.f, 0.f, 0.f, 0.f};
#pragma unroll
                    for (int kk = 0; kk < 4; ++kk) oT[ti] = MFMA16(sa[kk], bq[ti][kk], oT[ti]); }
            }
            __syncthreads();
            {
                bf16x8 va[2], bs[4][2];
#pragma unroll
                for (int kk = 0; kk < 2; ++kk) va[kk] = *(const LAS bf16x8*)(lds + GL_VT + (16 * wid + l15) * 144 + (32 * kk + 8 * l4) * 2);
#pragma unroll
                for (int ti = 0; ti < 4; ++ti)
#pragma unroll
                    for (int kk = 0; kk < 2; ++kk) bs[ti][kk] = *(const LAS bf16x8*)(lds + GL_SC + (16 * ti + l15) * 144 + (32 * kk + 8 * l4) * 2);
                __builtin_amdgcn_sched_barrier(0);
#pragma unroll
                for (int ti = 0; ti < 4; ++ti) {
#pragma unroll
                    for (int kk = 0; kk < 2; ++kk) oT[ti] = MFMA16(va[kk], bs[ti][kk], oT[ti]);
                    u32x2 w; w.x = cvt_pk_bf16(oT[ti][0], oT[ti][1]); w.y = cvt_pk_bf16(oT[ti][2], oT[ti][3]);
                    *(u32x2*)(od + (tok0 + 16 * ti + l15) * D + h * 256 + vs * 128 + 16 * wid + 4 * l4) = w; }
                const f32x4 dec = *(const LAS f32x4*)(lds + GL_DEC + (16 * wid + 4 * l4) * 4);
                bf16x8 ka[2], bv[8][2];
#pragma unroll
                for (int kk = 0; kk < 2; ++kk) ka[kk] = *(const LAS bf16x8*)(lds + GL_KET + (16 * wid + l15) * 144 + (32 * kk + 8 * l4) * 2);
#pragma unroll
                for (int tv = 0; tv < 8; ++tv)
#pragma unroll
                    for (int kk = 0; kk < 2; ++kk) bv[tv][kk] = *(const LAS bf16x8*)(lds + GL_VT + (16 * tv + l15) * 144 + (32 * kk + 8 * l4) * 2);
                __builtin_amdgcn_sched_barrier(0);
#pragma unroll
                for (int tv = 0; tv < 8; ++tv) { S[tv] = S[tv] * dec;
#pragma unroll
                    for (int kk = 0; kk < 2; ++kk) S[tv] = MFMA16(ka[kk], bv[tv][kk], S[tv]);
                    u32x2 w; w.x = cvt_pk_bf16(S[tv][0], S[tv][1]); w.y = cvt_pk_bf16(S[tv][2], S[tv][3]);
                    *(LAS u32x2*)(lds + GL_ST + (16 * tv + l15) * 272 + (16 * wid + 4 * l4) * 2) = w; }
            }
            __syncthreads();
        }
    }
}

#define XB_TMO      128
#define XB_XCNT(j)  (256  + 64 * (j))
#define XB_XSUB(j)  (1280 + 64 * (j))
#define XB_XGEN(j)  (2304 + 64 * (j))
#define XB_TOP      3328
#define XB_TOPGEN   3392
#define XCD_BAR_WORDS 3456
#define XB_SPIN_CAP (1u << 18)

__device__ __forceinline__ unsigned xb_ld(unsigned* p)              { return __hip_atomic_load(p, __ATOMIC_RELAXED, __HIP_MEMORY_SCOPE_AGENT); }
__device__ __forceinline__ unsigned xb_add(unsigned* p, unsigned v) { return __hip_atomic_fetch_add(p, v, __ATOMIC_RELAXED, __HIP_MEMORY_SCOPE_AGENT); }
__device__ __forceinline__ unsigned xb_xcc_id() { return (unsigned)__builtin_amdgcn_s_getreg((3 << 11) | 20) & 0xFu; }
#define XB_SPIN(cond, bar) do { unsigned _sp = 0; while (cond) { __builtin_amdgcn_s_sleep(1); \
    if ((++_sp & 255u) == 0u) { if (xb_ld(&(bar)[XB_TMO])) break; if (_sp > XB_SPIN_CAP) { atomicAdd(&(bar)[XB_TMO], 1u); break; } } } } while (0)

struct XcdBarrier {
    unsigned* bar; unsigned x;
    volatile LAS unsigned* st;
};

__device__ __forceinline__ XcdBarrier xcd_barrier_post(unsigned* bar, volatile LAS unsigned* st) {
    XcdBarrier b; b.bar = bar; b.x = xb_xcc_id(); b.st = st;
    if (threadIdx.x == 0) (void)xb_add(&bar[XB_XCNT(b.x)], 1u);
    return b;
}
__device__ __forceinline__ void xcd_barrier_complete(unsigned* bar, unsigned x, unsigned& nloc, unsigned& nx) {
    const unsigned G = gridDim.x * gridDim.y * gridDim.z;
    unsigned sum, cnt, mine, sp = 0u;
    for (;;) {
        sum = 0u; cnt = 0u; mine = 0u;
#pragma unroll
        for (unsigned j = 0; j < 16; ++j) { const unsigned c = xb_ld(&bar[XB_XCNT(j)]); sum += c; cnt += (c > 0u) ? 1u : 0u; mine = (j == x) ? c : mine; }
        if (sum == G) break;
        __builtin_amdgcn_s_sleep(1);
        if ((++sp & 255u) == 0u) { if (xb_ld(&bar[XB_TMO])) break; if (sp > XB_SPIN_CAP) { atomicAdd(&bar[XB_TMO], 1u); break; } }
    }
    nloc = mine > 0u ? mine : 1u; nx = cnt > 0u ? cnt : 1u;
}

__device__ __forceinline__ void xcd_barrier(const XcdBarrier& b) {
    asm volatile("s_waitcnt vmcnt(0)" ::: "memory");
    __syncthreads();
    if (threadIdx.x == 0) {
        unsigned* bar = b.bar;
        __builtin_amdgcn_s_waitcnt(0);
        unsigned nloc = b.st[0], nx = b.st[1];
        if (nloc == 0u) { xcd_barrier_complete(bar, b.x, nloc, nx); b.st[0] = nloc; b.st[1] = nx; }
        const unsigned old = xb_add(&bar[XB_XSUB(b.x)], 1u);
        const unsigned gen = old / nloc;
        if (old + 1u == (gen + 1u) * nloc) {
            __builtin_amdgcn_fence(__ATOMIC_RELEASE, "agent");
            asm volatile("s_waitcnt vmcnt(0)" ::: "memory");
            const unsigned og = xb_add(&bar[XB_TOP], 1u);
            const unsigned tg = og / nx;
            if (og + 1u == (tg + 1u) * nx) xb_add(&bar[XB_TOPGEN], 1u);
            else XB_SPIN(xb_ld(&bar[XB_TOPGEN]) == tg, bar);
            __builtin_amdgcn_fence(__ATOMIC_ACQUIRE, "agent");
            xb_add(&bar[XB_XGEN(b.x)], 1u);
            asm volatile("s_waitcnt vmcnt(0)" ::: "memory");
        } else {
            XB_SPIN(xb_ld(&bar[XB_XGEN(b.x)]) == gen, bar);
            __builtin_amdgcn_fence(__ATOMIC_ACQUIRE, "agent");
            asm volatile("s_waitcnt vmcnt(0)" ::: "memory");
        }
    }
    __syncthreads();
}

struct Args { const float* in[21]; float* out; unsigned char* ws; int nph, pad; unsigned char pl[32]; };
constexpr int N_PHASES = 12;

__global__ void __launch_bounds__(512, 2) fwd_kernel(Args args) {
    extern __shared__ __attribute__((aligned(16))) unsigned char lds_raw[];
    LAS unsigned char* lds = (LAS unsigned char*)lds_raw;
    const int G = gridDim.x;
    const int bx = blockIdx.x;
    const int vcu = (G % 8 == 0) ? (bx % 8) * (G / 8) + bx / 8 : bx;
    const int ngw = G * 8;
    unsigned char* ws = args.ws;
    const float* x = args.in[0];
    float* xo = args.out;
    float* SSQ = (float*)(ws + WS_SSQ);
    bf16_t* H = (bf16_t*)(ws + WS_H); bf16_t* MB = (bf16_t*)(ws + WS_MB); bf16_t* UB = (bf16_t*)(ws + WS_U); bf16_t* CAT = (bf16_t*)(ws + WS_CAT); bf16_t* OD = (bf16_t*)(ws + WS_OD);

    volatile LAS unsigned* bst = (volatile LAS unsigned*)(lds + 131072 + 1024);
    if (threadIdx.x < 2) bst[threadIdx.x] = 0u;
    __syncthreads();
    const XcdBarrier xbar = xcd_barrier_post((unsigned*)(ws + WS_BAR), bst);
    for (int ip = 0; ip < args.nph; ++ip) {
        const int pi = args.pl[ip];
        if (ip > 0) { if (args.pad) cg::this_grid().sync(); else xcd_barrier(xbar); }
        int tid = threadIdx.x; asm volatile("" : "+v"(tid));
        const int lane = tid & 63, wave = __builtin_amdgcn_readfirstlane(tid >> 6);
        const int gw = vcu * 8 + wave;
        const bf16_t* gA = nullptr; const bf16_t* gB = nullptr; int gN = 0, gK = 0, ekind = 0, eld = 0; bf16_t* eO = nullptr;
        int fz = -1;
        switch (pi) {
            case 1:  gA = H;   gB = (const bf16_t*)(ws + WS_W0IN);  gN = 2560; gK = 1024; ekind = 0; eO = UB;  eld = U0W; break;
            case 3:  gA = CAT; gB = (const bf16_t*)(ws + WS_W0OUT); gN = 1024; gK = 1024; fz = 0; break;
            case 4:  gA = (const bf16_t*)xo; gB = (const bf16_t*)(ws + WS_WGU0);  gN = 5632; gK = 1024; ekind = 1; eO = UB;  eld = DFF; break;
            case 5:  gA = UB;  gB = (const bf16_t*)(ws + WS_WDN0);  gN = 1024; gK = DFF;  fz = 1; break;
            case 6:  gA = (const bf16_t*)xo; gB = (const bf16_t*)(ws + WS_W1IN);  gN = U1W;  gK = 1024; ekind = 2; eO = UB;  eld = U1W; break;
            case 9:  gA = CAT; gB = (const bf16_t*)(ws + WS_W1OUT); gN = 1024; gK = 1024; fz = 2; break;
            case 10: gA = MB;  gB = (const bf16_t*)(ws + WS_WGU1);  gN = 5632; gK = 1024; ekind = 1; eO = UB;  eld = DFF; break;
            case 11: gA = UB;  gB = (const bf16_t*)(ws + WS_WDN1);  gN = 1024; gK = DFF;  fz = 3; break;
            case 12: gA = UB;  gB = (const bf16_t*)(ws + WS_WDN1);  gN = 1024; gK = DFF;  ekind = 2; eO = MB;  eld = D; break;
            case 13: gA = CAT; gB = (const bf16_t*)(ws + WS_W1OUT); gN = 1024; gK = 1024; ekind = 2; eO = MB;  eld = D; break;
            default: break;
        }
        if (gA && fz < 0) {
            pg8::Gemm g{gA, gB, M, gN, gK}; pg8::StaticOrder S; S.init(M, gN, G, bx);
            LAS float* rstab = (LAS float*)(lds + 131072 + 2048);
            if (tid < 256) {
                f32x4 qv[12];
#pragma unroll
                for (int i = 0; i < 12; ++i) { const int pmi = pg8::unit_pm(i, M / 256, gN / 256, G, bx); qv[i] = (f32x4){1024.f, 0.f, 0.f, 0.f}; if (pmi >= 0) qv[i] = *(const f32x4*)(SSQ + (size_t)(pmi * 256 + tid) * 4); }
#pragma unroll
                for (int i = 0; i < 12; ++i) rstab[i * 256 + tid] = 1.0f / sqrtf(((qv[i][0] + qv[i][1]) + (qv[i][2] + qv[i][3])) * (1.0f / 1024.0f) + EPS);
            }
            __syncthreads();
            pg8::EpiGen E{eO, eld, ekind, rstab};
            pg8::gemm_phase<pg8::EpiGen, pg8::StaticOrder, true, true, false>(lds, g, S, E, tid);
            continue;
        }
        if (gA) {
            const float* gpost = fz == 0 ? args.in[2] : fz == 1 ? args.in[4] : fz == 2 ? args.in[2] + D : args.in[4] + D;
            const void* xi = fz == 0 ? (const void*)x : fz == 3 ? (const void*)MB : (const void*)xo;
            void* xw = fz == 2 ? (void*)MB : (void*)xo;
            pg8::EpiFused E{xi, xw, fz == 0 ? 0 : 1, fz == 3 ? 0 : 1, gpost,
                            (float*)(ws + WS_XB + (size_t)fz * XB_BANK), (unsigned*)(ws + WS_CTL) + (size_t)fz * 128 * 64, fz == 3 ? nullptr : SSQ};
            pg8::Gemm g{gA, gB, M, gN, gK};
            const int rounds = (128 * 4 + G - 1) / G;
            for (int r = 0; r < rounds; ++r) {
                pg8::OneUnit S; S.so.init(M, gN, G, bx); S.round = r;
                pg8::gemm_phase<pg8::EpiFused, pg8::OneUnit, false, true, true>(lds, g, S, E, tid);
            }
            continue;
        }
        if (pi == 0) {
            LAS float* scr = (LAS float*)(lds + wave * 16384);
            int it = gw;
#define TR_MAT(Wp, Gp, Kk, Ns, WTp, Nd, kd) { const int items = ((Kk) / 64) * ((Nd) / 32); for (; it < items; it += ngw) p0_transpose_item((Wp), (Gp), (Kk), (Ns), (bf16_t*)(WTp), (kd), scr, it, (Nd), lane); it -= items; }
            TR_MAT(args.in[5], args.in[1], 1024, 2560, ws + WS_W0IN, 2560, 0)
            TR_MAT(args.in[11], nullptr, 1024, 1024, ws + WS_W0OUT, 1024, 2)
            TR_MAT(args.in[19], args.in[3], 1024, 5632, ws + WS_WGU0, 5632, 1)
            TR_MAT(args.in[19] + (size_t)1024 * 5632, args.in[3] + D, 1024, 5632, ws + WS_WGU1, 5632, 1)
            TR_MAT(args.in[20], nullptr, DFF, 1024, ws + WS_WDN0, 1024, 2)
            TR_MAT(args.in[20] + (size_t)DFF * 1024, nullptr, DFF, 1024, ws + WS_WDN1, 1024, 2)
            TR_MAT(args.in[12], args.in[1] + D, 1024, 3104, ws + WS_W1IN, U1W, 3)
            TR_MAT(args.in[18], nullptr, 1024, 1024, ws + WS_W1OUT, 1024, 2)
#undef TR_MAT
            cvt_phase(x, H, SSQ, gw, ngw, lane);
            __syncthreads();
        } else if (pi == 2) {
            conv_phase(lds, UB, args.in[6], args.in[7], args.in[8], args.in[9], args.in[10], CAT, G, tid);
        } else if (pi == 7) {
            gla_phase(lds, UB, args.in[13], args.in[14], args.in[15], args.in[16], OD, G, tid);
        } else if (pi == 8) {
            gla_combine_phase(OD, UB, args.in[17], CAT, gw, ngw, lane);
        }
    }
}

extern "C" void kernel_launch(void* const* d_in, const int* in_sizes, int n_in, void* d_out, int out_size, void* d_ws, size_t ws_size, hipStream_t stream) {
    static int grid = 0;
    if (grid == 0) {
        if (n_in != 21 || out_size != M * D || ws_size < WS_END) { fprintf(stderr, "kernel_launch: unexpected problem (n_in %d out %d ws %zu)\n", n_in, out_size, ws_size); grid = -1; return; }
        int dev = 0, cus = 0, per_cu = 0;
        hipGetDevice(&dev);
        hipDeviceGetAttribute(&cus, hipDeviceAttributeMultiprocessorCount, dev);
        if (hipFuncSetAttribute((const void*)fwd_kernel, hipFuncAttributeMaxDynamicSharedMemorySize, LDS_BYTES) != hipSuccess) { fprintf(stderr, "kernel_launch: hipFuncSetAttribute failed\n"); grid = -1; return; }
        if (hipOccupancyMaxActiveBlocksPerMultiprocessor(&per_cu, (const void*)fwd_kernel, 512, LDS_BYTES) != hipSuccess || per_cu < 1) { fprintf(stderr, "kernel_launch: occupancy query gave %d\n", per_cu); per_cu = 1; }
        (void)hipGetLastError();
        grid = cus * per_cu;
    }
    if (grid < 0) return;
    if (hipMemsetAsync((char*)d_ws + WS_CTL, 0, CTL_BYTES, stream) != hipSuccess) { fprintf(stderr, "kernel_launch: memset failed\n"); return; }
    Args a{};
    for (int i = 0; i < 21; ++i) a.in[i] = (const float*)d_in[i];
    a.out = (float*)d_out; a.ws = (unsigned char*)d_ws;
#if MK_ONE_LAUNCH
#ifndef PROBE_DUP
#define PROBE_DUP -1
#endif

    { int n = 0; for (int p = 0; p < N_PHASES; ++p) { a.pl[n++] = (unsigned char)p; if (p == PROBE_DUP) a.pl[n++] = (unsigned char)p; } a.nph = n; }
#ifdef PROBE_EXTRA
    a.pl[a.nph++] = PROBE_EXTRA;
#endif
#ifdef PROBE_NULLS
    for (int i = 0; i < PROBE_NULLS; ++i) a.pl[a.nph++] = 15;
#endif
    void* kargs[] = {&a};
    hipError_t e = hipLaunchCooperativeKernel((const void*)fwd_kernel, dim3(grid), dim3(512), kargs, LDS_BYTES, stream);
    if (e != hipSuccess) fprintf(stderr, "cooperative launch failed: %s (grid %d)\n", hipGetErrorString(e), grid);
#else
    for (int p = 0; p < N_PHASES; ++p) {
        a.nph = 1; a.pl[0] = (unsigned char)p;
        hipLaunchKernelGGL(fwd_kernel, dim3(grid), dim3(512), LDS_BYTES, stream, a);
        if (p == PROBE_P) hipLaunchKernelGGL(fwd_kernel, dim3(grid), dim3(512), LDS_BYTES, stream, a);
    }
#endif
}
```

```cpp
#include <hip/hip_runtime.h>
#include <hip/hip_cooperative_groups.h>
#include <cstdio>
#include <cstdint>
namespace cg = cooperative_groups;

#ifndef MK_ONE_LAUNCH
#define MK_ONE_LAUNCH 1
#ifndef PROBE_P
#define PROBE_P -1
#endif
#endif

#define LAS __attribute__((address_space(3)))
typedef unsigned short bf16_t;
typedef short bf16x8 __attribute__((ext_vector_type(8)));
typedef float f32x4 __attribute__((ext_vector_type(4)));
typedef float f32x16 __attribute__((ext_vector_type(16)));
typedef unsigned u32x4 __attribute__((ext_vector_type(4)));
typedef unsigned u32x2 __attribute__((ext_vector_type(2)));
typedef float f32x2 __attribute__((ext_vector_type(2)));

constexpr int SEQ = 2048, NB = 16, D = 1024, M = NB * SEQ;
constexpr int DFF = 2816;
constexpr int U0W = 1536;
constexpr int U1W = 3328;
constexpr float EPS = 1e-6f;

constexpr size_t MiB = 1u << 20;
constexpr size_t WS_CTL = 0, CTL_CNT_BYTES = 8 * 128 * 64 * 4, WS_BAR = CTL_CNT_BYTES, CTL_BYTES = CTL_CNT_BYTES + 16384;
constexpr size_t WS_XB = 52 * MiB, XB_BANK = 128 * 256 * 4 * 4;
constexpr size_t WS_SSQ = 56 * MiB;
constexpr size_t WS_W0IN = 2 * MiB, WS_W0OUT = 7 * MiB, WS_WGU0 = 9 * MiB, WS_WGU1 = 20 * MiB, WS_WDN0 = 31 * MiB, WS_WDN1 = 37 * MiB,
                 WS_W1IN = 43 * MiB, WS_W1OUT = 50 * MiB;
constexpr size_t WS_H = 64 * MiB;
constexpr size_t WS_MB = 128 * MiB;
constexpr size_t WS_OD = 64 * MiB;
constexpr size_t WS_U = 192 * MiB;
constexpr size_t WS_CAT = 400 * MiB;
constexpr size_t WS_END = 464 * MiB;

constexpr int LDS_BYTES = 147456;

typedef __bf16 bf16x2_t __attribute__((ext_vector_type(2)));
__device__ __forceinline__ unsigned cvt_pk_bf16(float lo, float hi) { const f32x2 v = {lo, hi}; return __builtin_bit_cast(unsigned, __builtin_convertvector(v, bf16x2_t)); }
__device__ __forceinline__ unsigned f2bf(float f) { unsigned u = __builtin_bit_cast(unsigned, f); return (u + 0x7fffu + ((u >> 16) & 1u)) >> 16; }
__device__ __forceinline__ float bf2f(unsigned b) { return __builtin_bit_cast(float, b << 16); }
__device__ __forceinline__ float bflo(unsigned w) { return __builtin_bit_cast(float, w << 16); }
__device__ __forceinline__ float bfhi(unsigned w) { return __builtin_bit_cast(float, w & 0xffff0000u); }
__device__ __forceinline__ float sigmoidf_(float x) { return __builtin_amdgcn_rcpf(1.0f + __expf(-x)); }
#define DPP_F(v, ctrl) __builtin_bit_cast(float, __builtin_amdgcn_update_dpp(0, __builtin_bit_cast(int, (v)), (ctrl), 0xF, 0xF, true))
__device__ __forceinline__ float row16_sum(float v) { v += DPP_F(v, 0xB1); v += DPP_F(v, 0x4E); v += DPP_F(v, 0x141); v += DPP_F(v, 0x140); return v; }
__device__ __forceinline__ float wave_sum(float v) {
    v = row16_sum(v);
    const float a = __builtin_bit_cast(float, __builtin_amdgcn_readlane(__builtin_bit_cast(int, v), 0)), b = __builtin_bit_cast(float, __builtin_amdgcn_readlane(__builtin_bit_cast(int, v), 16)),
                c = __builtin_bit_cast(float, __builtin_amdgcn_readlane(__builtin_bit_cast(int, v), 32)), d = __builtin_bit_cast(float, __builtin_amdgcn_readlane(__builtin_bit_cast(int, v), 48));
    return (a + b) + (c + d);
}

namespace pg8 {
#define PG8_LAS __attribute__((address_space(3)))
constexpr int BM = 256, BK = 64, HALF = 128, HTB = HALF * BK * 2, STAGE_BYTES = 8 * HTB, NXCD = 8, WGM = 8;
__host__ __device__ __forceinline__ int lds_byte(int r, int c) { const int st = (r >> 4) * 2 + (c >> 5), rr = r & 15, cc = c & 31, ob = rr * 64 + cc * 2; return st * 1024 + (ob ^ (((ob >> 9) & 1) << 5)); }
__host__ __device__ __forceinline__ void stage_rc(int b, int& R, int& C) { const int st = b / 1024, sb = b % 1024, swz = sb ^ (((sb >> 9) & 1) << 5); R = (st >> 1) * 16 + swz / 64; C = (st & 1) * 32 + (swz % 64) / 2; }
__host__ __device__ __forceinline__ int perm32(int rho) { const int n = rho >> 4, i = rho & 15; return 8 * (i >> 2) + 4 * n + (i & 3); }

struct Unit { int pm, pn; };
__device__ __forceinline__ int unit_pm(int i, int nM, int nN, int G, int c) {
    const int nwg = nM * nN; const long L = (long)i * G + c; if (L >= nwg) return -1;
    int wgid = (int)L; { const int q = nwg / 8, r = nwg % 8, xcd = wgid % 8, off = wgid / 8; wgid = (xcd < r ? xcd * (q + 1) : r * (q + 1) + (xcd - r) * q) + off; }
    const int nig = 8 * nN, gid = wgid / nig, fm = gid * 8, gsz = (nM - fm) < 8 ? (nM - fm) : 8;
    return fm + ((wgid % nig) % gsz);
}

struct Gemm { const bf16_t* A; const bf16_t* Bt; int M, N, K; };

struct StaticOrder {
    int nM, nN, nwg, G, c;
    __host__ __device__ void init(int M_, int N_, int G_, int c_) { nM = M_ / BM; nN = N_ / BM; nwg = nM * nN; G = G_; c = c_; }
    __host__ __device__ bool next(int i, Unit& u) const {
        const long L = (long)i * G + c; if (L >= nwg) return false;
        int wgid = (int)L; { const int q = nwg / NXCD, r = nwg % NXCD, xcd = wgid % NXCD, off = wgid / NXCD; wgid = (xcd < r ? xcd * (q + 1) : r * (q + 1) + (xcd - r) * q) + off; }
        const int nig = WGM * nN, gid = wgid / nig, fm = gid * WGM, gsz = (nM - fm) < WGM ? (nM - fm) : WGM;
        u.pm = fm + ((wgid % nig) % gsz); u.pn = (wgid % nig) / gsz; return true;
    }
    __host__ __device__ int pm_of(int i) const {
        const long L = (long)i * G + c; if (L >= nwg) return -1;
        int wgid = (int)L; { const int q = nwg / NXCD, r = nwg % NXCD, xcd = wgid % NXCD, off = wgid / NXCD; wgid = (xcd < r ? xcd * (q + 1) : r * (q + 1) + (xcd - r) * q) + off; }
        const int nig = WGM * nN, gid = wgid / nig, fm = gid * WGM, gsz = (nM - fm) < WGM ? (nM - fm) : WGM;
        return fm + ((wgid % nig) % gsz);
    }
};

struct EpiGen {
    static constexpr bool PERM = true;
    bf16_t* O; int ldc; int kind; const PG8_LAS float* rstab;
    __device__ __forceinline__ void operator()(const f32x4 (&acc)[2][2][4][2], const Unit& u, int wr, int wc, int fr, int fq, int ui) const {
        const int row0 = u.pm * BM + wr * 64 + fr;
        const PG8_LAS float* rst = rstab + ui * 256 + wr * 64 + fr;
        const int cw = wc * 32 + 8 * fq;
        int mode = 0, colbase = u.pn * BM;
        if (kind == 0) { if (u.pn < 4) { mode = 1; colbase = u.pn * 128; } else if (u.pn < 8) { mode = 2; colbase = 512 + (u.pn - 4) * 128; } else { colbase = 1024 + (u.pn - 8) * 256; } }
        else if (kind == 1) { mode = 3; colbase = u.pn * 128; }
        if (mode == 0) {
#pragma unroll
            for (int ai = 0; ai < 2; ++ai)
#pragma unroll
                for (int m = 0; m < 4; ++m) {
                    const int row = row0 + ai * HALF + m * 16;
                    bf16_t* rowp = O + (size_t)row * ldc + colbase + cw;
                    const float rs = rst[ai * HALF + m * 16];
#pragma unroll
                    for (int bj = 0; bj < 2; ++bj) { const f32x4 v0 = acc[ai][bj][m][0] * rs, v1 = acc[ai][bj][m][1] * rs;
                        u32x4 w; w.x = cvt_pk_bf16(v0[0], v0[1]); w.y = cvt_pk_bf16(v0[2], v0[3]); w.z = cvt_pk_bf16(v1[0], v1[1]); w.w = cvt_pk_bf16(v1[2], v1[3]);
                        *(u32x4*)(rowp + bj * HALF) = w; }
                }
        } else if (mode == 1) gated<1>(acc, rst, O + (size_t)row0 * ldc + colbase + cw);
        else if (mode == 2) gated<2>(acc, rst, O + (size_t)row0 * ldc + colbase + cw);
        else gated<3>(acc, rst, O + (size_t)row0 * ldc + colbase + cw);
    }
    template <int MODE> __device__ __forceinline__ void gated(const f32x4 (&acc)[2][2][4][2], const PG8_LAS float* rst, bf16_t* base) const {
#pragma unroll
        for (int ai = 0; ai < 2; ++ai)
#pragma unroll
            for (int m = 0; m < 4; ++m) {
                const float rs = rst[ai * HALF + m * 16]; const float rs2 = rs * rs, nrl = rs * -1.4426950408889634f;
                unsigned w[4];
#pragma unroll
                for (int n = 0; n < 2; ++n)
#pragma unroll
                    for (int h = 0; h < 2; ++h) {
                        const f32x2 a = {acc[ai][0][m][n][2 * h], acc[ai][0][m][n][2 * h + 1]}, b = {acc[ai][1][m][n][2 * h], acc[ai][1][m][n][2 * h + 1]};
                        f32x2 o = (a * b) * rs2;
                        if (MODE != 2) { const f32x2 t = (MODE == 1 ? b : a) * nrl; f32x2 d; d.x = __builtin_amdgcn_exp2f(t.x); d.y = __builtin_amdgcn_exp2f(t.y); d = d + 1.0f;
                            f32x2 r; r.x = __builtin_amdgcn_rcpf(d.x); r.y = __builtin_amdgcn_rcpf(d.y);
                            o = MODE == 1 ? (a * rs) * r : o * r; }
                        w[n * 2 + h] = cvt_pk_bf16(o.x, o.y);
                    }
                *(u32x4*)(base + (size_t)(ai * HALF + m * 16) * ldc) = (u32x4){w[0], w[1], w[2], w[3]};
            }
    }
};

struct OneUnit { StaticOrder so; int round;
    __device__ __forceinline__ bool next(int i, Unit& u) const { return i == 0 ? so.next(round, u) : false; } };

__device__ __forceinline__ void panel_rstd(const f32x4 (&v)[2][2][4][2], const Unit& u, int wr, int wc, int fr, int fq, PG8_LAS unsigned char* lds, int wid, int lane, float* xbuf, unsigned* cnt) {
    PG8_LAS float* P = (PG8_LAS float*)lds;
    PG8_LAS float* S = (PG8_LAS float*)(lds + 8192);
#pragma unroll
    for (int ai = 0; ai < 2; ++ai)
#pragma unroll
        for (int m = 0; m < 4; ++m) {
            float s = 0.f;
#pragma unroll
            for (int bj = 0; bj < 2; ++bj)
#pragma unroll
                for (int n = 0; n < 2; ++n) { const f32x4 x = v[ai][bj][m][n]; s += (x[0] * x[0] + x[1] * x[1]) + (x[2] * x[2] + x[3] * x[3]); }
            s += __shfl_xor(s, 16); s += __shfl_xor(s, 32);
            if (fq == 0) P[(ai * HALF + wr * 64 + m * 16 + fr) * 4 + wc] = s;
        }
    asm volatile("s_waitcnt lgkmcnt(0)" ::: "memory"); __builtin_amdgcn_s_barrier(); asm volatile("" ::: "memory");
    const int row = wid * 32 + (lane & 31);
    if (lane < 32) {
        const f32x4 p = *(const PG8_LAS f32x4*)(P + row * 4);
        const float t = (p[0] + p[1]) + (p[2] + p[3]);
        __hip_atomic_store((unsigned*)xbuf + ((size_t)(u.pm * BM + row) * 4 + u.pn), __builtin_bit_cast(unsigned, t), __ATOMIC_RELAXED, __HIP_MEMORY_SCOPE_AGENT);
    }
    asm volatile("s_waitcnt vmcnt(0)" ::: "memory");
    if (lane == 0) __hip_atomic_fetch_add(cnt + 64 * u.pm, 1u, __ATOMIC_RELAXED, __HIP_MEMORY_SCOPE_AGENT);
    if (wid == 0) {
        unsigned spins = 0;
        while ((unsigned)__builtin_amdgcn_readfirstlane(__hip_atomic_load(cnt + 64 * u.pm, __ATOMIC_RELAXED, __HIP_MEMORY_SCOPE_AGENT)) < 32u) { __builtin_amdgcn_s_sleep(2); if (++spins > (1u << 22)) break; }
        __builtin_amdgcn_fence(__ATOMIC_ACQUIRE, "agent");
    }
    asm volatile("s_waitcnt vmcnt(0) lgkmcnt(0)" ::: "memory"); __builtin_amdgcn_s_barrier(); asm volatile("" ::: "memory");
    if (lane < 32) {
        const unsigned* slot = (const unsigned*)xbuf + (size_t)(u.pm * BM + row) * 4; float tot = 0.f;
#pragma unroll
        for (int t = 0; t < 4; ++t) tot += __builtin_bit_cast(float, __hip_atomic_load(slot + t, __ATOMIC_RELAXED, __HIP_MEMORY_SCOPE_AGENT));
        S[row] = 1.0f / sqrtf(tot * (1.0f / 1024.0f) + 1e-6f);
    }
    asm volatile("s_waitcnt lgkmcnt(0)" ::: "memory"); __builtin_amdgcn_s_barrier(); asm volatile("" ::: "memory");
}

struct EpiFused {
    static constexpr bool PERM = true;
    const void* xin; void* xout; int in_bf, out_bf; const float* gpost; float* xb1; unsigned* cnt1; float* ssq;
    __device__ __forceinline__ void operator()(const f32x4 (&)[2][2][4][2], const Unit&, int, int, int, int, int) const {}
    __device__ __forceinline__ void fused(f32x4 (&acc)[2][2][4][2], const Unit& u, int wr, int wc, int fr, int fq, PG8_LAS unsigned char* lds, int wid, int lane) const {
        PG8_LAS float* P = (PG8_LAS float*)lds;
        const PG8_LAS float* S = (const PG8_LAS float*)(lds + 8192);
        const int col0 = u.pn * BM + wc * 32 + 8 * fq;
        u32x4 xw[4][2];
        if (in_bf) {
#pragma unroll
            for (int m = 0; m < 4; ++m)
#pragma unroll
                for (int bj = 0; bj < 2; ++bj) xw[m][bj] = *(const u32x4*)((const bf16_t*)xin + (size_t)(u.pm * BM + wr * 64 + m * 16 + fr) * 1024 + col0 + bj * HALF);
        }
        panel_rstd(acc, u, wr, wc, fr, fq, lds, wid, lane, xb1, cnt1);
        f32x4 g[2][2];
#pragma unroll
        for (int bj = 0; bj < 2; ++bj)
#pragma unroll
            for (int n = 0; n < 2; ++n) g[bj][n] = *(const f32x4*)(gpost + col0 + bj * HALF + 4 * n);
#pragma unroll
        for (int ai = 0; ai < 2; ++ai)
#pragma unroll
            for (int m = 0; m < 4; ++m) { const int r = ai * HALF + wr * 64 + m * 16 + fr; const float rs = S[r]; const size_t off = (size_t)(u.pm * BM + r) * 1024 + col0;
                float sq = 0.f;
#pragma unroll
                for (int bj = 0; bj < 2; ++bj) {
                    f32x4 b0, b1;
                    if (in_bf) { const u32x4 w = ai == 0 ? xw[m][bj] : *(const u32x4*)((const bf16_t*)xin + off + bj * HALF); b0 = (f32x4){bflo(w.x), bfhi(w.x), bflo(w.y), bfhi(w.y)}; b1 = (f32x4){bflo(w.z), bfhi(w.z), bflo(w.w), bfhi(w.w)}; }
                    else { b0 = *(const f32x4*)((const float*)xin + off + bj * HALF); b1 = *(const f32x4*)((const float*)xin + off + bj * HALF + 4); }
                    const f32x4 o0 = b0 + acc[ai][bj][m][0] * rs * g[bj][0], o1 = b1 + acc[ai][bj][m][1] * rs * g[bj][1];
                    sq += (o0[0] * o0[0] + o0[1] * o0[1]) + (o0[2] * o0[2] + o0[3] * o0[3]) + (o1[0] * o1[0] + o1[1] * o1[1]) + (o1[2] * o1[2] + o1[3] * o1[3]);
                    if (out_bf) { u32x4 w; w.x = cvt_pk_bf16(o0[0], o0[1]); w.y = cvt_pk_bf16(o0[2], o0[3]); w.z = cvt_pk_bf16(o1[0], o1[1]); w.w = cvt_pk_bf16(o1[2], o1[3]); *(u32x4*)((bf16_t*)xout + off + bj * HALF) = w; }
                    else { *(f32x4*)((float*)xout + off + bj * HALF) = o0; *(f32x4*)((float*)xout + off + bj * HALF + 4) = o1; } }
                sq += __shfl_xor(sq, 16); sq += __shfl_xor(sq, 32);
                if (fq == 0) P[r * 4 + wc] = sq;
                if (m & 1) asm volatile("" ::: "memory"); }
        asm volatile("s_waitcnt lgkmcnt(0)" ::: "memory"); __builtin_amdgcn_s_barrier(); asm volatile("" ::: "memory");
        if (ssq && lane < 32) { const int row = wid * 32 + lane; const f32x4 p = *(const PG8_LAS f32x4*)(P + row * 4); ssq[(size_t)(u.pm * BM + row) * 4 + u.pn] = (p[0] + p[1]) + (p[2] + p[3]); }
        asm volatile("s_waitcnt lgkmcnt(0)" ::: "memory"); __builtin_amdgcn_s_barrier(); asm volatile("" ::: "memory");
    }
};

template <class Epi, class Sched, bool ALIGN_EPI, bool SP2, bool FUSED>
__device__ __forceinline__ void gemm_phase(PG8_LAS unsigned char* lds, const Gemm g, const Sched& S, const Epi& E, const int tid) {
    const int wid = __builtin_amdgcn_readfirstlane(tid >> 6), lane = tid & 63, wr = wid >> 2, wc = wid & 3, fr = lane & 15, fq = lane >> 4;
    const int K = g.K, nt = K / BK;
    unsigned voffA[2], voffB[2];
#pragma unroll
    for (int i = 0; i < 2; ++i) { int R, C; stage_rc(tid * 16 + i * 8192, R, C); const int Rb = Epi::PERM ? ((R & ~31) + perm32(R & 31)) : R;
        voffA[i] = (unsigned)(R * K + C) * 2u; voffB[i] = (unsigned)(Rb * K + C) * 2u; }
    const size_t kstep = (size_t)(BK * 2);
    const size_t hstep = (size_t)HALF * K * 2;
    const size_t tstep = 2 * hstep;
    const unsigned ldsw = (unsigned)wid * 1024u;
    const int aoff = lds_byte(wr * 64 + fr, fq * 8), boff = lds_byte(wc * 32 + fr, fq * 8);
#define PG8_SA(b, h) (((b) * 2 + (h)) * HTB)
#define PG8_SB(b, h) ((4 + (b) * 2 + (h)) * HTB)
#define PG8_STAGE(bufoff, gbase, voff) do { _Pragma("unroll") for (int _i = 0; _i < 2; ++_i) \
        __builtin_amdgcn_global_load_lds((const unsigned*)((const char*)(gbase) + (voff)[_i]), (PG8_LAS unsigned*)(lds + (bufoff) + ldsw + _i * 8192), 16, 0, 0); } while (0)
#define PG8_LDA(dst, b, h) do { _Pragma("unroll") for (int m = 0; m < 4; ++m) _Pragma("unroll") for (int k = 0; k < 2; ++k) dst[m][k] = *(const PG8_LAS bf16x8*)(lds + PG8_SA(b, h) + aoff + m * 2048 + k * 1024); } while (0)
#define PG8_LDB(dst, b, h) do { _Pragma("unroll") for (int n = 0; n < 2; ++n) _Pragma("unroll") for (int k = 0; k < 2; ++k) dst[n][k] = *(const PG8_LAS bf16x8*)(lds + PG8_SB(b, h) + boff + n * 2048 + k * 1024); } while (0)
#define PG8_MMA(ai, bj, At, Bt) do { __builtin_amdgcn_s_setprio(1); _Pragma("unroll") for (int m = 0; m < 4; ++m) _Pragma("unroll") for (int n = 0; n < 2; ++n) _Pragma("unroll") for (int k = 0; k < 2; ++k) \
        acc[ai][bj][m][n] = __builtin_amdgcn_mfma_f32_16x16x32_bf16(Bt[n][k], At[m][k], acc[ai][bj][m][n], 0, 0, 0); __builtin_amdgcn_s_setprio(0); } while (0)
#define PG8_WAIT_V(n) asm volatile("s_waitcnt vmcnt(" #n ")" ::: "memory")
#define PG8_WAIT_L(n) asm volatile("s_waitcnt lgkmcnt(" #n ")" ::: "memory")
#define PG8_BAR __builtin_amdgcn_s_barrier()
#define PG8_SCHED __builtin_amdgcn_sched_barrier(0)
    Unit cur, nxt; int ui = 0;
    if (!S.next(0, cur)) return;
    f32x4 acc[2][2][4][2];
#pragma unroll
    for (int a = 0; a < 2; ++a)
#pragma unroll
        for (int b = 0; b < 2; ++b)
#pragma unroll
            for (int m = 0; m < 4; ++m)
#pragma unroll
                for (int n = 0; n < 2; ++n) acc[a][b][m][n] = (f32x4){0.f, 0.f, 0.f, 0.f};
    bf16x8 At[4][2], B0[2][2], B1[2][2];
    const char* cA = (const char*)g.A + (size_t)cur.pm * tstep; const char* cB = (const char*)g.Bt + (size_t)cur.pn * tstep;
    if constexpr (SP2) {
        PG8_STAGE(PG8_SB(0, 0), cB, voffB); PG8_STAGE(PG8_SB(0, 1), cB + hstep, voffB); PG8_STAGE(PG8_SA(0, 0), cA, voffA); PG8_STAGE(PG8_SA(0, 1), cA + hstep, voffA);
        if (wr == 1) PG8_BAR;
        PG8_WAIT_V(2); PG8_BAR;
        PG8_STAGE(PG8_SB(1, 0), cB + kstep, voffB); PG8_STAGE(PG8_SA(1, 0), cA + kstep, voffA); PG8_STAGE(PG8_SB(1, 1), cB + hstep + kstep, voffB);
        PG8_WAIT_V(6); PG8_BAR;
    } else {
        PG8_STAGE(PG8_SB(0, 0), cB, voffB); PG8_STAGE(PG8_SA(0, 0), cA, voffA); PG8_STAGE(PG8_SB(0, 1), cB + hstep, voffB); PG8_STAGE(PG8_SA(0, 1), cA + hstep, voffA);
        if (wr == 1) PG8_BAR;
        PG8_WAIT_V(4); PG8_BAR;
        PG8_STAGE(PG8_SB(1, 0), cB + kstep, voffB); PG8_STAGE(PG8_SA(1, 0), cA + kstep, voffA); PG8_STAGE(PG8_SB(1, 1), cB + hstep + kstep, voffB);
        PG8_WAIT_V(6); PG8_BAR;
    }
    for (;;) {
        const bool has_next = S.next(ui + 1, nxt);
        const char* nA = has_next ? (const char*)g.A + (size_t)nxt.pm * tstep : cA; const char* nB = has_next ? (const char*)g.Bt + (size_t)nxt.pn * tstep : cB;
        for (int t = 0; t < nt; t += 2) {
            const bool last = (t == nt - 2);
            const char* a1 = cA + (size_t)(t + 1) * kstep;
            const char* a2 = last ? nA : cA + (size_t)(t + 2) * kstep; const char* b2 = last ? nB : cB + (size_t)(t + 2) * kstep;
            const char* a3 = a2 + kstep; const char* b3 = b2 + kstep;
            if constexpr (SP2) {
            PG8_LDB(B0, 0, 0); PG8_LDB(B1, 0, 1); PG8_SCHED; PG8_LDA(At, 0, 0); PG8_STAGE(PG8_SA(1, 1), a1 + hstep, voffA);
            PG8_WAIT_V(8); PG8_WAIT_L(0); PG8_BAR; PG8_MMA(0, 0, At, B0); PG8_MMA(0, 1, At, B1); PG8_BAR; PG8_SCHED;
            PG8_LDA(At, 0, 1); PG8_STAGE(PG8_SB(0, 0), b2, voffB); PG8_STAGE(PG8_SB(0, 1), b2 + hstep, voffB); PG8_STAGE(PG8_SA(0, 0), a2, voffA);
            PG8_WAIT_V(8); PG8_WAIT_L(0); PG8_BAR; PG8_MMA(1, 0, At, B0); PG8_MMA(1, 1, At, B1); PG8_BAR; PG8_SCHED;
            PG8_LDB(B0, 1, 0); PG8_LDB(B1, 1, 1); PG8_SCHED; PG8_LDA(At, 1, 0); PG8_STAGE(PG8_SA(0, 1), a2 + hstep, voffA);
            PG8_WAIT_V(8); PG8_WAIT_L(0); PG8_BAR; PG8_MMA(0, 0, At, B0); PG8_MMA(0, 1, At, B1); PG8_BAR; PG8_SCHED;
            PG8_LDA(At, 1, 1); PG8_STAGE(PG8_SB(1, 0), b3, voffB); PG8_STAGE(PG8_SB(1, 1), b3 + hstep, voffB); PG8_STAGE(PG8_SA(1, 0), a3, voffA);
            PG8_WAIT_V(8); PG8_WAIT_L(0); PG8_BAR; PG8_MMA(1, 0, At, B0); PG8_MMA(1, 1, At, B1); PG8_BAR; PG8_SCHED;
            } else {
            PG8_LDB(B0, 0, 0); PG8_SCHED; PG8_LDA(At, 0, 0); PG8_STAGE(PG8_SA(1, 1), a1 + hstep, voffA);
            PG8_WAIT_L(8); PG8_BAR; PG8_WAIT_L(0); PG8_MMA(0, 0, At, B0); PG8_BAR; PG8_SCHED;
            PG8_LDB(B1, 0, 1); PG8_STAGE(PG8_SB(0, 0), b2, voffB);
            PG8_BAR; PG8_WAIT_L(0); PG8_MMA(0, 1, At, B1); PG8_BAR;
            PG8_LDA(At, 0, 1); PG8_STAGE(PG8_SA(0, 0), a2, voffA);
            PG8_BAR; PG8_WAIT_L(0); PG8_MMA(1, 0, At, B0); PG8_BAR; PG8_SCHED;
            PG8_STAGE(PG8_SB(0, 1), b2 + hstep, voffB);
            PG8_WAIT_V(6); PG8_BAR; PG8_MMA(1, 1, At, B1); PG8_BAR;
            PG8_LDB(B0, 1, 0); PG8_SCHED; PG8_LDA(At, 1, 0); PG8_STAGE(PG8_SA(0, 1), a2 + hstep, voffA);
            PG8_WAIT_L(8); PG8_BAR; PG8_WAIT_L(0); PG8_MMA(0, 0, At, B0); PG8_BAR; PG8_SCHED;
            PG8_LDB(B1, 1, 1); PG8_STAGE(PG8_SB(1, 0), b3, voffB);
            PG8_BAR; PG8_WAIT_L(0); PG8_MMA(0, 1, At, B1); PG8_BAR;
            PG8_LDA(At, 1, 1); PG8_STAGE(PG8_SA(1, 0), a3, voffA);
            PG8_BAR; PG8_WAIT_L(0); PG8_MMA(1, 0, At, B0); PG8_BAR; PG8_SCHED;
            PG8_STAGE(PG8_SB(1, 1), b3 + hstep, voffB);
            PG8_WAIT_V(6); PG8_BAR; PG8_MMA(1, 1, At, B1); PG8_BAR;
            }
        }
        if constexpr (ALIGN_EPI) { if (wr == 0) PG8_BAR; }
        if constexpr (!FUSED) E(acc, cur, wr, wc, fr, fq, ui);
        if (!has_next) break;
#pragma unroll
        for (int a = 0; a < 2; ++a)
#pragma unroll
            for (int b = 0; b < 2; ++b)
#pragma unroll
                for (int m = 0; m < 4; ++m)
#pragma unroll
                    for (int n = 0; n < 2; ++n) acc[a][b][m][n] = (f32x4){0.f, 0.f, 0.f, 0.f};
        cur = nxt; cA = nA; cB = nB; ++ui;
        if constexpr (ALIGN_EPI) { if (wr == 1) PG8_BAR; }
    }
    PG8_WAIT_V(0);
    if constexpr (!ALIGN_EPI) { if (wr == 0) PG8_BAR; }
    PG8_BAR;
    if constexpr (FUSED) E.fused(acc, cur, wr, wc, fr, fq, lds, wid, lane);
#undef PG8_SA
#undef PG8_SB
#undef PG8_STAGE
#undef PG8_LDA
#undef PG8_LDB
#undef PG8_MMA
#undef PG8_WAIT_V
#undef PG8_WAIT_L
#undef PG8_BAR
#undef PG8_SCHED
}
}

__device__ __forceinline__ int srccol(int kind, int n0, int nsrc) {
    if (kind == 0) { const int t = n0 >> 8, w = n0 & 255, bj = w >> 7, j = w & 127;
        if (t < 4) return bj == 0 ? 128 * t + j : 512 + 128 * t + j;
        if (t < 8) return bj == 0 ? 1536 + 128 * (t - 4) + j : 2048 + 128 * (t - 4) + j;
        return 1024 + 256 * (t - 8) + w; }
    if (kind == 1) { const int pn = n0 >> 8, w = n0 & 255, bj = w >> 7, j = w & 127; return bj * DFF + 128 * pn + j; }
    return n0 < nsrc ? n0 : -1;
}
__device__ __forceinline__ void p0_tr_load(const float* W, const float* gk, int K, int N, int kind, int item, int ndst, int lane, float (&tmp)[32], int& k0, int& n0) {
    const int nblk = ndst / 32, kb = item / nblk, nb = item % nblk; k0 = 64 * kb; n0 = 32 * nb;
    const int sc = srccol(kind, n0, N);
    const float wsc = (kind == 3 && n0 < 512) ? 0.08838834764831845f : 1.0f;
#pragma unroll
    for (int i = 0; i < 32; ++i) { const int kk = 2 * i + (lane >> 5); tmp[i] = sc >= 0 ? W[(size_t)(k0 + kk) * N + sc + (lane & 31)] * (gk ? gk[k0 + kk] * wsc : wsc) : 0.f; }
}
__device__ __forceinline__ void p0_tr_store(int K, bf16_t* WT, LAS float* scr, int lane, const float (&tmp)[32], int k0, int n0) {
#pragma unroll
    for (int i = 0; i < 32; ++i) { const int kk = 2 * i + (lane >> 5); scr[kk * 33 + (lane & 31)] = tmp[i]; }
    asm volatile("s_waitcnt lgkmcnt(0)" ::: "memory");
    const int c = lane & 7;
#pragma unroll
    for (int j = 0; j < 4; ++j) { const int n = (lane >> 3) + 8 * j; const LAS float* sp = scr + (8 * c) * 33 + n;
        u32x4 o; o.x = cvt_pk_bf16(sp[0 * 33], sp[1 * 33]); o.y = cvt_pk_bf16(sp[2 * 33], sp[3 * 33]); o.z = cvt_pk_bf16(sp[4 * 33], sp[5 * 33]); o.w = cvt_pk_bf16(sp[6 * 33], sp[7 * 33]);
        *(u32x4*)(WT + (size_t)(n0 + n) * K + k0 + 8 * c) = o; }
    asm volatile("s_waitcnt lgkmcnt(0)" ::: "memory");
}
__device__ __forceinline__ void p0_transpose_item2(const float* W, const float* gk, int K, int N, bf16_t* WT, int kind, LAS float* scr, int item, int item2, int ndst, int lane) {
    float ta[32], tb[32]; int k0a, n0a, k0b = 0, n0b = 0;
    p0_tr_load(W, gk, K, N, kind, item, ndst, lane, ta, k0a, n0a);
    if (item2 >= 0) p0_tr_load(W, gk, K, N, kind, item2, ndst, lane, tb, k0b, n0b);
    p0_tr_store(K, WT, scr, lane, ta, k0a, n0a);
    if (item2 >= 0) p0_tr_store(K, WT, scr, lane, tb, k0b, n0b);
}

__device__ __forceinline__ void norm_phase(const float* xin, const bf16_t* mb, const float* ss, const float* gpost, const float* gpre, float* xout, bf16_t* h, int gw, int ngw, int lane) {
    for (int row0 = gw; row0 < M; row0 += 2 * ngw) {
        const bool two = row0 + ngw < M;
        f32x4 v[2][4]; u32x2 mw[2][4]; float sv[2];
#pragma unroll
        for (int r = 0; r < 2; ++r) { if (r == 1 && !two) break; const int row = row0 + r * ngw;
            const f32x4* xr = (const f32x4*)(xin + (size_t)row * D) + lane;
#pragma unroll
            for (int j = 0; j < 4; ++j) v[r][j] = xr[64 * j];
            if (mb) { sv[r] = ss[(size_t)row * 16 + (lane & 15)]; const u32x2* mr = (const u32x2*)(mb + (size_t)row * D) + lane;
#pragma unroll
                for (int j = 0; j < 4; ++j) mw[r][j] = mr[64 * j]; } }
#pragma unroll
        for (int r = 0; r < 2; ++r) { if (r == 1 && !two) break; const int row = row0 + r * ngw;
            if (mb) {
                const float rs = 1.0f / sqrtf(row16_sum(sv[r]) * (1.0f / D) + EPS);
#pragma unroll
                for (int j = 0; j < 4; ++j) { const u32x2 w = mw[r][j]; const f32x4 g = ((const f32x4*)gpost)[64 * j + lane];
                    v[r][j][0] += bflo(w.x) * rs * g[0]; v[r][j][1] += bfhi(w.x) * rs * g[1]; v[r][j][2] += bflo(w.y) * rs * g[2]; v[r][j][3] += bfhi(w.y) * rs * g[3]; }
            }
            if (xout) { f32x4* xo = (f32x4*)(xout + (size_t)row * D) + lane;
#pragma unroll
                for (int j = 0; j < 4; ++j) xo[64 * j] = v[r][j]; }
            if (h) {
                float s2 = 0.f;
#pragma unroll
                for (int j = 0; j < 4; ++j) s2 += (v[r][j][0] * v[r][j][0] + v[r][j][1] * v[r][j][1]) + (v[r][j][2] * v[r][j][2] + v[r][j][3] * v[r][j][3]);
                const float rs = 1.0f / sqrtf(wave_sum(s2) * (1.0f / D) + EPS);
                u32x2* ho = (u32x2*)(h + (size_t)row * D) + lane;
#pragma unroll
                for (int j = 0; j < 4; ++j) { const f32x4 g = ((const f32x4*)gpre)[64 * j + lane]; u32x2 w; w.x = cvt_pk_bf16(v[r][j][0] * rs * g[0], v[r][j][1] * rs * g[1]); w.y = cvt_pk_bf16(v[r][j][2] * rs * g[2], v[r][j][3] * rs * g[3]); ho[64 * j] = w; }
            }
        }
    }
}

__device__ __forceinline__ void cvt_phase(const float* xin, bf16_t* xb, float* ssq, int gw, int ngw, int lane) {
    constexpr int R = 4;
    for (int row0 = gw; row0 < M; row0 += R * ngw) {
        f32x4 v[R][4];
#pragma unroll
        for (int r = 0; r < R; ++r) { if (row0 + r * ngw >= M) break; const f32x4* xr = (const f32x4*)(xin + (size_t)(row0 + r * ngw) * D) + lane;
#pragma unroll
            for (int j = 0; j < 4; ++j) v[r][j] = __builtin_nontemporal_load(xr + 64 * j); }
#pragma unroll
        for (int r = 0; r < R; ++r) { const int row = row0 + r * ngw; if (row >= M) break;
            float s2 = 0.f; u32x2* ho = (u32x2*)(xb + (size_t)row * D) + lane;
#pragma unroll
            for (int j = 0; j < 4; ++j) { s2 += (v[r][j][0] * v[r][j][0] + v[r][j][1] * v[r][j][1]) + (v[r][j][2] * v[r][j][2] + v[r][j][3] * v[r][j][3]);
                u32x2 w; w.x = cvt_pk_bf16(v[r][j][0], v[r][j][1]); w.y = cvt_pk_bf16(v[r][j][2], v[r][j][3]); ho[64 * j] = w; }
            s2 = wave_sum(s2);
            if (lane == 0) *(f32x4*)(ssq + (size_t)row * 4) = (f32x4){s2, 0.f, 0.f, 0.f};
        }
    }
}

__device__ __forceinline__ void gla_combine_phase(const bf16_t* od, const bf16_t* u1, const float* gn, bf16_t* og, int gw, int ngw, int lane) {
    for (int row0 = gw; row0 < M; row0 += 2 * ngw) {
        const bool two = row0 + ngw < M;
        u32x2 wa[2][4], wb[2][4], wr_[2][4];
#pragma unroll
        for (int r = 0; r < 2; ++r) { if (r == 1 && !two) break; const int row = row0 + r * ngw;
            const u32x2* a = (const u32x2*)(od + (size_t)row * D) + lane;
            const u32x2* b = (const u32x2*)(od + (size_t)M * D + (size_t)row * D) + lane;
            const u32x2* rr = (const u32x2*)(u1 + (size_t)row * U1W + 2048) + lane;
#pragma unroll
            for (int j = 0; j < 4; ++j) { wa[r][j] = a[64 * j]; wb[r][j] = b[64 * j]; wr_[r][j] = rr[64 * j]; } }
#pragma unroll
        for (int r = 0; r < 2; ++r) { if (r == 1 && !two) break; const int row = row0 + r * ngw;
            u32x2* o = (u32x2*)(og + (size_t)row * D) + lane;
#pragma unroll
            for (int j = 0; j < 4; ++j) {
                const f32x4 g = ((const f32x4*)gn)[64 * j + lane];
                float v0 = bflo(wa[r][j].x) + bflo(wb[r][j].x), v1 = bfhi(wa[r][j].x) + bfhi(wb[r][j].x), v2 = bflo(wa[r][j].y) + bflo(wb[r][j].y), v3 = bfhi(wa[r][j].y) + bfhi(wb[r][j].y);
                const float s = wave_sum((v0 * v0 + v1 * v1) + (v2 * v2 + v3 * v3));
                const float rs = 1.0f / sqrtf(s * (1.0f / 256.0f) + EPS);
                const float r0 = bflo(wr_[r][j].x), r1 = bfhi(wr_[r][j].x), r2 = bflo(wr_[r][j].y), r3 = bfhi(wr_[r][j].y);
                v0 = v0 * rs * g[0] * (r0 * sigmoidf_(r0)); v1 = v1 * rs * g[1] * (r1 * sigmoidf_(r1)); v2 = v2 * rs * g[2] * (r2 * sigmoidf_(r2)); v3 = v3 * rs * g[3] * (r3 * sigmoidf_(r3));
                u32x2 w; w.x = cvt_pk_bf16(v0, v1); w.y = cvt_pk_bf16(v2, v3); o[64 * j] = w;
            }
        }
    }
}

constexpr int CT = 32;
constexpr int CV_IN_ROWS = CT + 30;
constexpr int CV_OUT_OFF = CV_IN_ROWS * 1024;
__device__ __forceinline__ void conv_phase(LAS unsigned char* lds, const bf16_t* U0, const float* dw_w, const float* dw_b, const float* ln_g, const float* ln_b, const float* sc_w, bf16_t* CAT, int G, const int tid) {
    const int wid = tid >> 6, lane = tid & 63;
    const int p = tid & 255, th = tid >> 8;
    f32x2 w2[31];
#pragma unroll
    for (int k = 0; k < 31; ++k) w2[k] = *(const f32x2*)(dw_w + k * 512 + 2 * p);
    const f32x2 bias = *(const f32x2*)(dw_b + 2 * p);
    LAS float* OUT = (LAS float*)(lds + CV_OUT_OFF);
    for (int item = blockIdx.x; item < M / CT; item += G) {
        const int tok0 = item * CT, s0 = tok0 % SEQ, bbase = tok0 - s0;
        {
            u32x4 sv[8];
#pragma unroll
            for (int e = 0; e < 8; ++e) { const int c = tid + 512 * e, r = c >> 6, ch = c & 63; const int s = s0 - 15 + r;
                sv[e] = (u32x4){0u, 0u, 0u, 0u};
                if (c < CV_IN_ROWS * 64 && s >= 0 && s < SEQ) sv[e] = *(const u32x4*)(U0 + (size_t)(bbase + s) * U0W + ch * 8); }
#pragma unroll
            for (int e = 0; e < 8; ++e) { const int c = tid + 512 * e, r = c >> 6, ch = c & 63;
                if (c < CV_IN_ROWS * 64) *(LAS u32x4*)(lds + r * 1024 + ch * 16) = sv[e]; }
        }
        __syncthreads();
        {
            f32x2 a2[16];
#pragma unroll
            for (int i = 0; i < 16; ++i) a2[i] = bias;
#pragma unroll
            for (int jr = 0; jr < 46; ++jr) {
                const unsigned w = *(const LAS unsigned*)(lds + (16 * th + jr) * 1024 + p * 4);
                const f32x2 x2 = {bflo(w), bfhi(w)};
#pragma unroll
                for (int i = 0; i < 16; ++i) { const int kk = jr - i; if (kk >= 0 && kk <= 30) a2[i] = __builtin_elementwise_fma(w2[kk], x2, a2[i]); }
            }
#pragma unroll
            for (int i = 0; i < 16; ++i) *(LAS f32x2*)(OUT + (16 * th + i) * 512 + 2 * p) = a2[i];
        }
        __syncthreads();
        for (int t = wid; t < CT; t += 8) {
            f32x4 a = *(const LAS f32x4*)(OUT + t * 512 + 4 * lane), b = *(const LAS f32x4*)(OUT + t * 512 + 256 + 4 * lane);
            const float mean = wave_sum((a[0] + a[1]) + (a[2] + a[3]) + (b[0] + b[1]) + (b[2] + b[3])) * (1.0f / 512.0f);
            a = a - mean; b = b - mean;
            const float var = wave_sum((a[0] * a[0] + a[1] * a[1]) + (a[2] * a[2] + a[3] * a[3]) + (b[0] * b[0] + b[1] * b[1]) + (b[2] * b[2] + b[3] * b[3])) * (1.0f / 512.0f);
            const float rs = 1.0f / sqrtf(var + EPS);
            const f32x4 ga = *(const f32x4*)(ln_g + 4 * lane), gb = *(const f32x4*)(ln_g + 256 + 4 * lane), ba = *(const f32x4*)(ln_b + 4 * lane), bb = *(const f32x4*)(ln_b + 256 + 4 * lane);
            float ya[4], yb[4];
#pragma unroll
            for (int j = 0; j < 4; ++j) { const float y = a[j] * rs * ga[j] + ba[j]; ya[j] = y * sigmoidf_(y); const float z = b[j] * rs * gb[j] + bb[j]; yb[j] = z * sigmoidf_(z); }
            bf16_t* orow = CAT + (size_t)(tok0 + t) * D;
            u32x2 wa; wa.x = cvt_pk_bf16(ya[0], ya[1]); wa.y = cvt_pk_bf16(ya[2], ya[3]); *(u32x2*)(orow + 4 * lane) = wa;
            u32x2 wb; wb.x = cvt_pk_bf16(yb[0], yb[1]); wb.y = cvt_pk_bf16(yb[2], yb[3]); *(u32x2*)(orow + 256 + 4 * lane) = wb;
        }
#pragma unroll
        for (int c = tid; c < CT * 64; c += 512) { const int t = c >> 6, ch = (c & 63) * 8; const int s = s0 + t; const size_t row = (size_t)(tok0 + t);
            const bf16_t* cvp = U0 + row * U0W + 512 + ch;
            const u32x4 c0 = *(const u32x4*)cvp;
            u32x4 cm = (u32x4){0u, 0u, 0u, 0u}, cp = (u32x4){0u, 0u, 0u, 0u};
            if (s > 0) cm = *(const u32x4*)(cvp - U0W);
            if (s < SEQ - 1) cp = *(const u32x4*)(cvp + U0W);
            const u32x4 bg = *(const u32x4*)(U0 + row * U0W + 1024 + ch);
            float r[8];
#pragma unroll
            for (int q = 0; q < 4; ++q) {
                const float wm0 = sc_w[ch + 2 * q], wm1 = sc_w[ch + 2 * q + 1], wc0 = sc_w[512 + ch + 2 * q], wc1 = sc_w[512 + ch + 2 * q + 1], wp0 = sc_w[1024 + ch + 2 * q], wp1 = sc_w[1024 + ch + 2 * q + 1];
                r[2 * q] = bflo(bg[q]) * (wm0 * bflo(cm[q]) + wc0 * bflo(c0[q]) + wp0 * bflo(cp[q]));
                r[2 * q + 1] = bfhi(bg[q]) * (wm1 * bfhi(cm[q]) + wc1 * bfhi(c0[q]) + wp1 * bfhi(cp[q]));
            }
            u32x4 o; o.x = cvt_pk_bf16(r[0], r[1]); o.y = cvt_pk_bf16(r[2], r[3]); o.z = cvt_pk_bf16(r[4], r[5]); o.w = cvt_pk_bf16(r[6], r[7]);
            *(u32x4*)(CAT + row * D + 512 + ch) = o; }
    }
    __syncthreads();
}

constexpr int GL_QB = 0, GL_KB = 17408, GL_KET = 34816, GL_VT = 53248, GL_LA = 34816, GL_SC = 71680, GL_ST = 80896, GL_DEC = 115712, GL_GT = 116224;
#define MFMA16(a, b, c) __builtin_amdgcn_mfma_f32_16x16x32_bf16((a), (b), (c), 0, 0, 0)
__device__ __forceinline__ void gla_phase(LAS unsigned char* lds, const bf16_t* U, const float* wa2f, const float* ba2f, const float* wa2b, const float* ba2b, bf16_t* OD, int G, const int tid) {
    const int wid = __builtin_amdgcn_readfirstlane(tid >> 6), lane = tid & 63;
    const int l15 = lane & 15, l4 = lane >> 4;
    const float L2E = 1.4426950408889634f;
    for (int cid = blockIdx.x; cid < 256; cid += G) {
        const int vs = cid & 1, dir = (cid >> 1) & 1, h = (cid >> 2) & 3, b = cid >> 4;
        const float* wa2 = dir ? wa2b : wa2f; const float* ba2 = dir ? ba2b : ba2f;
        const int tr = wid >> 2, tc = wid & 3;
        bf16x8 wb;
#pragma unroll
        for (int j = 0; j < 8; ++j) wb[j] = (short)f2bf(wa2[(8 * (lane >> 5) + j) * 512 + h * 128 + 32 * tc + (lane & 31)]);
        const float zb = ba2[h * 128 + 32 * tc + (lane & 31)];
        f32x4 S[8];
#pragma unroll
        for (int i = 0; i < 8; ++i) S[i] = (f32x4){0.f, 0.f, 0.f, 0.f};
        for (int c = tid; c < 34816 / 16; c += 512) *(LAS u32x4*)(lds + GL_ST + c * 16) = (u32x4){0u, 0u, 0u, 0u};
        __syncthreads();
        bf16_t* od = OD + (size_t)dir * M * D;
        const size_t offg = (size_t)(32 * tr + (lane & 31)) * U1W + 3072 + dir * 16 + 8 * (lane >> 5);
        size_t offq[2];
#pragma unroll
        for (int e = 0; e < 2; ++e) { const int c = tid + 512 * e, t = c >> 4, kc = c & 15; offq[e] = (size_t)t * U1W + h * 128 + kc * 8; }
        size_t offv[2];
#pragma unroll
        for (int e = 0; e < 2; ++e) { const int c = tid + 512 * e, t = c & 63, vc = c >> 6; offv[e] = (size_t)t * U1W + 1024 + h * 256 + vs * 128 + vc * 8; }
        bf16x8 ga; u32x4 qreg[2], kreg[2], vreg[2];
        {
            const int n = dir ? 31 : 0; const bf16_t* base = U + ((size_t)b * SEQ + (size_t)n * 64) * U1W;
            ga = *(const bf16x8*)(base + offg);
#pragma unroll
            for (int e = 0; e < 2; ++e) { qreg[e] = *(const u32x4*)(base + offq[e]); kreg[e] = *(const u32x4*)(base + offq[e] + 512); vreg[e] = *(const u32x4*)(base + offv[e]); }
        }
        for (int step = 0; step < 32; ++step) {
            const int n = dir ? 31 - step : step; const size_t tok0 = (size_t)b * SEQ + (size_t)n * 64;
            u32x4 vcur[2];
            {
                f32x16 z;
#pragma unroll
                for (int i = 0; i < 16; ++i) z[i] = 0.f;
                z = __builtin_amdgcn_mfma_f32_32x32x16_bf16(ga, wb, z, 0, 0, 0);
#pragma unroll
                for (int e = 0; e < 2; ++e) { const int c = tid + 512 * e, t = c >> 4, kc = c & 15;
                    *(LAS u32x4*)(lds + GL_QB + t * 272 + kc * 16) = qreg[e]; *(LAS u32x4*)(lds + GL_KB + t * 272 + kc * 16) = kreg[e]; vcur[e] = vreg[e]; }
                const float nzb = zb * -L2E;
#pragma unroll
                for (int i = 0; i < 16; i += 2) {
                    f32x2 t = {z[i], z[i + 1]}; t = __builtin_elementwise_min(t * -L2E + nzb, (f32x2){126.f, 126.f});
                    f32x2 d; d.x = __builtin_amdgcn_exp2f(t.x); d.y = __builtin_amdgcn_exp2f(t.y); d = d + 1.0f;
                    f32x2 l; l.x = __builtin_amdgcn_logf(d.x); l.y = __builtin_amdgcn_logf(d.y); l = l * (-1.0f / 16.0f);
                    const int row = (i & 3) + 8 * (i >> 2) + 4 * (lane >> 5);
                    *(LAS float*)(lds + GL_LA + ((32 * tr + row) * 128 + 32 * tc + (lane & 31)) * 4) = l.x;
                    *(LAS float*)(lds + GL_LA + ((32 * tr + row + 1) * 128 + 32 * tc + (lane & 31)) * 4) = l.y; }
            }
            __syncthreads();
            const int kp = lane, tg = wid;
            f32x2 pc[8];
#pragma unroll
            for (int i = 0; i < 8; ++i) pc[i] = *(const LAS f32x2*)(lds + GL_LA + ((8 * tg + i) * 128 + 2 * kp) * 4);
            if (dir == 0) {
#pragma unroll
                for (int i = 1; i < 8; ++i) pc[i] += pc[i - 1];
                *(LAS f32x2*)(lds + GL_GT + (tg * 128 + 2 * kp) * 4) = pc[7];
            } else {
#pragma unroll
                for (int i = 6; i >= 0; --i) pc[i] += pc[i + 1];
                *(LAS f32x2*)(lds + GL_GT + (tg * 128 + 2 * kp) * 4) = pc[0];
            }
            __syncthreads();
            {
                const int sn = step < 31 ? step + 1 : step; const int nn = dir ? 31 - sn : sn; const bf16_t* base = U + ((size_t)b * SEQ + (size_t)nn * 64) * U1W;
                ga = *(const bf16x8*)(base + offg);
#pragma unroll
                for (int e = 0; e < 2; ++e) { qreg[e] = *(const u32x4*)(base + offq[e]); kreg[e] = *(const u32x4*)(base + offq[e] + 512); vreg[e] = *(const u32x4*)(base + offv[e]); }
            }
            {
                f32x2 tot = (f32x2){0.f, 0.f}, off = (f32x2){0.f, 0.f};
#pragma unroll
                for (int t = 0; t < 8; ++t) { const f32x2 g = *(const LAS f32x2*)(lds + GL_GT + (t * 128 + 2 * kp) * 4); tot += g; const bool take = dir == 0 ? (t < tg) : (t > tg); if (take) off += g; }
                f32x2 et; et.x = __builtin_amdgcn_exp2f(tot[0]); et.y = __builtin_amdgcn_exp2f(tot[1]);
                const float et0 = et.x, et1 = et.y;
                float ke0[8], ke1[8];
#pragma unroll
                for (int i = 0; i < 8; ++i) {
                    const f32x2 c = pc[i] + off;
                    f32x2 E, iE; E.x = __builtin_amdgcn_exp2f(c.x); E.y = __builtin_amdgcn_exp2f(c.y); iE.x = __builtin_amdgcn_rcpf(E.x); iE.y = __builtin_amdgcn_rcpf(E.y);
                    LAS unsigned* qp = (LAS unsigned*)(lds + GL_QB + (8 * tg + i) * 272 + kp * 4);
                    LAS unsigned* kq = (LAS unsigned*)(lds + GL_KB + (8 * tg + i) * 272 + kp * 4);
                    const unsigned qw = *qp, kw = *kq;
                    const f32x2 qt = (f32x2){bflo(qw), bfhi(qw)} * E, kt = (f32x2){bflo(kw), bfhi(kw)} * iE, ke = kt * et;
                    *qp = cvt_pk_bf16(qt.x, qt.y);
                    *kq = cvt_pk_bf16(kt.x, kt.y);
                    ke0[i] = ke.x; ke1[i] = ke.y;
                }
                *(LAS u32x4*)(lds + GL_KET + (2 * kp) * 144 + tg * 16) = (u32x4){cvt_pk_bf16(ke0[0], ke0[1]), cvt_pk_bf16(ke0[2], ke0[3]), cvt_pk_bf16(ke0[4], ke0[5]), cvt_pk_bf16(ke0[6], ke0[7])};
                *(LAS u32x4*)(lds + GL_KET + (2 * kp + 1) * 144 + tg * 16) = (u32x4){cvt_pk_bf16(ke1[0], ke1[1]), cvt_pk_bf16(ke1[2], ke1[3]), cvt_pk_bf16(ke1[4], ke1[5]), cvt_pk_bf16(ke1[6], ke1[7])};
                if (tg == 0) *(LAS f32x2*)(lds + GL_DEC + 2 * kp * 4) = (f32x2){et0, et1};
#pragma unroll
                for (int e = 0; e < 2; ++e) { const int c = tid + 512 * e, t = c & 63, vc = c >> 6;
#pragma unroll
                    for (int x = 0; x < 4; ++x) { const unsigned w = vcur[e][x];
                        *(LAS bf16_t*)(lds + GL_VT + (vc * 8 + 2 * x) * 144 + t * 2) = (bf16_t)(w & 0xffffu);
                        *(LAS bf16_t*)(lds + GL_VT + (vc * 8 + 2 * x + 1) * 144 + t * 2) = (bf16_t)(w >> 16); } }
            }
            __syncthreads();
            f32x4 oT[4];
            {
                bf16x8 fa[2][4], fb[2][4];
#pragma unroll
                for (int e = 0; e < 2; ++e) { const int t = 2 * wid + e, tj = t >> 2, ti = t & 3;
#pragma unroll
                    for (int kk = 0; kk < 4; ++kk) {
                        fa[e][kk] = *(const LAS bf16x8*)(lds + GL_KB + (16 * tj + l15) * 272 + (32 * kk + 8 * l4) * 2);
                        fb[e][kk] = *(const LAS bf16x8*)(lds + GL_QB + (16 * ti + l15) * 272 + (32 * kk + 8 * l4) * 2); } }
                __builtin_amdgcn_sched_barrier(0);
#pragma unroll
                for (int e = 0; e < 2; ++e) { const int t = 2 * wid + e, tj = t >> 2, ti = t & 3;
                    f32x4 sc = (f32x4){0.f, 0.f, 0.f, 0.f};
#pragma unroll
                    for (int kk = 0; kk < 4; ++kk) sc = MFMA16(fa[e][kk], fb[e][kk], sc);
                    const int i = 16 * ti + l15, j0 = 16 * tj + 4 * l4;
                    float m[4];
#pragma unroll
                    for (int x = 0; x < 4; ++x) { const int j = j0 + x; const bool keep = dir == 0 ? (j <= i) : (j >= i); m[x] = keep ? sc[x] : 0.f; }
                    u32x2 w; w.x = cvt_pk_bf16(m[0], m[1]); w.y = cvt_pk_bf16(m[2], m[3]);
                    *(LAS u32x2*)(lds + GL_SC + i * 144 + j0 * 2) = w; }
                bf16x8 sa[4], bq[4][4];
#pragma unroll
                for (int kk = 0; kk < 4; ++kk) sa[kk] = *(const LAS bf16x8*)(lds + GL_ST + (16 * wid + l15) * 272 + (32 * kk + 8 * l4) * 2);
#pragma unroll
                for (int ti = 0; ti < 4; ++ti)
#pragma unroll
                    for (int kk = 0; kk < 4; ++kk) bq[ti][kk] = *(const LAS bf16x8*)(lds + GL_QB + (16 * ti + l15) * 272 + (32 * kk + 8 * l4) * 2);
                __builtin_amdgcn_sched_barrier(0);
#pragma unroll
                for (int ti = 0; ti < 4; ++ti) { oT[ti] = (f32x4){0.f, 0.f, 0.f, 0.f};
#pragma unroll
                    for (int kk = 0; kk < 4; ++kk) oT[ti] = MFMA16(sa[kk], bq[ti][kk], oT[ti]); }
            }
            __syncthreads();
            {
                bf16x8 va[2], bs[4][2];
#pragma unroll
                for (int kk = 0; kk < 2; ++kk) va[kk] = *(const LAS bf16x8*)(lds + GL_VT + (16 * wid + l15) * 144 + (32 * kk + 8 * l4) * 2);
#pragma unroll
                for (int ti = 0; ti < 4; ++ti)
#pragma unroll
                    for (int kk = 0; kk < 2; ++kk) bs[ti][kk] = *(const LAS bf16x8*)(lds + GL_SC + (16 * ti + l15) * 144 + (32 * kk + 8 * l4) * 2);
                __builtin_amdgcn_sched_barrier(0);
#pragma unroll
                for (int ti = 0; ti < 4; ++ti) {
#pragma unroll
                    for (int kk = 0; kk < 2; ++kk) oT[ti] = MFMA16(va[kk], bs[ti][kk], oT[ti]);
                    u32x2 w; w.x = cvt_pk_bf16(oT[ti][0], oT[ti][1]); w.y = cvt_pk_bf16(oT[ti][2], oT[ti][3]);
                    *(u32x2*)(od + (tok0 + 16 * ti + l15) * D + h * 256 + vs * 128 + 16 * wid + 4 * l4) = w; }
                const f32x4 dec = *(const LAS f32x4*)(lds + GL_DEC + (16 * wid + 4 * l4) * 4);
                bf16x8 ka[2], bv[8][2];
#pragma unroll
                for (int kk = 0; kk < 2; ++kk) ka[kk] = *(const LAS bf16x8*)(lds + GL_KET + (16 * wid + l15) * 144 + (32 * kk + 8 * l4) * 2);
#pragma unroll
                for (int tv = 0; tv < 8; ++tv)
#pragma unroll
                    for (int kk = 0; kk < 2; ++kk) bv[tv][kk] = *(const LAS bf16x8*)(lds + GL_VT + (16 * tv + l15) * 144 + (32 * kk + 8 * l4) * 2);
                __builtin_amdgcn_sched_barrier(0);
#pragma unroll
                for (int tv = 0; tv < 8; ++tv) { S[tv] = S[tv] * dec;
#pragma unroll
                    for (int kk = 0; kk < 2; ++kk) S[tv] = MFMA16(ka[kk], bv[tv][kk], S[tv]);
                    u32x2 w; w.x = cvt_pk_bf16(S[tv][0], S[tv][1]); w.y = cvt_pk_bf16(S[tv][2], S[tv][3]);
                    *(LAS u32x2*)(lds + GL_ST + (16 * tv + l15) * 272 + (16 * wid + 4 * l4) * 2) = w; }
            }
            __syncthreads();
        }
    }
}

#define XB_TMO      128
#define XB_XCNT(j)  (256  + 64 * (j))
#define XB_XSUB(j)  (1280 + 64 * (j))
#define XB_XGEN(j)  (2304 + 64 * (j))
#define XB_TOP      3328
#define XB_TOPGEN   3392
#define XCD_BAR_WORDS 3456
#define XB_SPIN_CAP (1u << 18)

__device__ __forceinline__ unsigned xb_ld(unsigned* p)              { return __hip_atomic_load(p, __ATOMIC_RELAXED, __HIP_MEMORY_SCOPE_AGENT); }
__device__ __forceinline__ unsigned xb_add(unsigned* p, unsigned v) { return __hip_atomic_fetch_add(p, v, __ATOMIC_RELAXED, __HIP_MEMORY_SCOPE_AGENT); }
__device__ __forceinline__ unsigned xb_xcc_id() { return (unsigned)__builtin_amdgcn_s_getreg((3 << 11) | 20) & 0xFu; }
#define XB_SPIN(cond, bar) do { unsigned _sp = 0; while (cond) { __builtin_amdgcn_s_sleep(1); \
    if ((++_sp & 255u) == 0u) { if (xb_ld(&(bar)[XB_TMO])) break; if (_sp > XB_SPIN_CAP) { atomicAdd(&(bar)[XB_TMO], 1u); break; } } } } while (0)

struct XcdBarrier {
    unsigned* bar; unsigned x;
    volatile LAS unsigned* st;
};

__device__ __forceinline__ XcdBarrier xcd_barrier_post(unsigned* bar, volatile LAS unsigned* st) {
    XcdBarrier b; b.bar = bar; b.x = xb_xcc_id(); b.st = st;
    if (threadIdx.x == 0) (void)xb_add(&bar[XB_XCNT(b.x)], 1u);
    return b;
}
__device__ __forceinline__ void xcd_barrier_complete(unsigned* bar, unsigned x, unsigned& nloc, unsigned& nx) {
    const unsigned G = gridDim.x * gridDim.y * gridDim.z;
    unsigned sum, cnt, mine, sp = 0u;
    for (;;) {
        sum = 0u; cnt = 0u; mine = 0u;
#pragma unroll
        for (unsigned j = 0; j < 16; ++j) { const unsigned c = xb_ld(&bar[XB_XCNT(j)]); sum += c; cnt += (c > 0u) ? 1u : 0u; mine = (j == x) ? c : mine; }
        if (sum == G) break;
        __builtin_amdgcn_s_sleep(1);
        if ((++sp & 255u) == 0u) { if (xb_ld(&bar[XB_TMO])) break; if (sp > XB_SPIN_CAP) { atomicAdd(&bar[XB_TMO], 1u); break; } }
    }
    nloc = mine > 0u ? mine : 1u; nx = cnt > 0u ? cnt : 1u;
}

__device__ __forceinline__ void xcd_barrier(const XcdBarrier& b) {
    asm volatile("s_waitcnt vmcnt(0)" ::: "memory");
    __syncthreads();
    if (threadIdx.x == 0) {
        unsigned* bar = b.bar;
        __builtin_amdgcn_s_waitcnt(0);
        unsigned nloc = b.st[0], nx = b.st[1];
        if (nloc == 0u) { xcd_barrier_complete(bar, b.x, nloc, nx); b.st[0] = nloc; b.st[1] = nx; }
        const unsigned old = xb_add(&bar[XB_XSUB(b.x)], 1u);
        const unsigned gen = old / nloc;
        if (old + 1u == (gen + 1u) * nloc) {
            __builtin_amdgcn_fence(__ATOMIC_RELEASE, "agent");
            asm volatile("s_waitcnt vmcnt(0)" ::: "memory");
            const unsigned og = xb_add(&bar[XB_TOP], 1u);
            const unsigned tg = og / nx;
            if (og + 1u == (tg + 1u) * nx) xb_add(&bar[XB_TOPGEN], 1u);
            else XB_SPIN(xb_ld(&bar[XB_TOPGEN]) == tg, bar);
            __builtin_amdgcn_fence(__ATOMIC_ACQUIRE, "agent");
            xb_add(&bar[XB_XGEN(b.x)], 1u);
            asm volatile("s_waitcnt vmcnt(0)" ::: "memory");
        } else {
            XB_SPIN(xb_ld(&bar[XB_XGEN(b.x)]) == gen, bar);
            __builtin_amdgcn_fence(__ATOMIC_ACQUIRE, "agent");
            asm volatile("s_waitcnt vmcnt(0)" ::: "memory");
        }
    }
    __syncthreads();
}

struct Args { const float* in[21]; float* out; unsigned char* ws; int nph, pad; unsigned char pl[32]; };
constexpr int N_PHASES = 12;

__global__ void __launch_bounds__(512, 2) fwd_kernel(Args args) {
    extern __shared__ __attribute__((aligned(16))) unsigned char lds_raw[];
    LAS unsigned char* lds = (LAS unsigned char*)lds_raw;
    const int G = gridDim.x;
    const int bx = blockIdx.x;
    const int vcu = (G % 8 == 0) ? (bx % 8) * (G / 8) + bx / 8 : bx;
    const int ngw = G * 8;
    unsigned char* ws = args.ws;
    const float* x = args.in[0];
    float* xo = args.out;
    float* SSQ = (float*)(ws + WS_SSQ);
    bf16_t* H = (bf16_t*)(ws + WS_H); bf16_t* MB = (bf16_t*)(ws + WS_MB); bf16_t* UB = (bf16_t*)(ws + WS_U); bf16_t* CAT = (bf16_t*)(ws + WS_CAT); bf16_t* OD = (bf16_t*)(ws + WS_OD);

    volatile LAS unsigned* bst = (volatile LAS unsigned*)(lds + 131072 + 1024);
    if (threadIdx.x < 2) bst[threadIdx.x] = 0u;
    __syncthreads();
    const XcdBarrier xbar = xcd_barrier_post((unsigned*)(ws + WS_BAR), bst);
    for (int ip = 0; ip < args.nph; ++ip) {
        const int pi = args.pl[ip];
        if (ip > 0) { if (args.pad) cg::this_grid().sync(); else xcd_barrier(xbar); }
        int tid = threadIdx.x; asm volatile("" : "+v"(tid));
        const int lane = tid & 63, wave = __builtin_amdgcn_readfirstlane(tid >> 6);
        const int gw = vcu * 8 + wave;
        const bf16_t* gA = nullptr; const bf16_t* gB = nullptr; int gN = 0, gK = 0, ekind = 0, eld = 0; bf16_t* eO = nullptr;
        int fz = -1;
        switch (pi) {
            case 1:  gA = H;   gB = (const bf16_t*)(ws + WS_W0IN);  gN = 2560; gK = 1024; ekind = 0; eO = UB;  eld = U0W; break;
            case 3:  gA = CAT; gB = (const bf16_t*)(ws + WS_W0OUT); gN = 1024; gK = 1024; fz = 0; break;
            case 4:  gA = (const bf16_t*)xo; gB = (const bf16_t*)(ws + WS_WGU0);  gN = 5632; gK = 1024; ekind = 1; eO = UB;  eld = DFF; break;
            case 5:  gA = UB;  gB = (const bf16_t*)(ws + WS_WDN0);  gN = 1024; gK = DFF;  fz = 1; break;
            case 6:  gA = (const bf16_t*)xo; gB = (const bf16_t*)(ws + WS_W1IN);  gN = U1W;  gK = 1024; ekind = 2; eO = UB;  eld = U1W; break;
            case 9:  gA = CAT; gB = (const bf16_t*)(ws + WS_W1OUT); gN = 1024; gK = 1024; fz = 2; break;
            case 10: gA = MB;  gB = (const bf16_t*)(ws + WS_WGU1);  gN = 5632; gK = 1024; ekind = 1; eO = UB;  eld = DFF; break;
            case 11: gA = UB;  gB = (const bf16_t*)(ws + WS_WDN1);  gN = 1024; gK = DFF;  fz = 3; break;
            case 12: gA = UB;  gB = (const bf16_t*)(ws + WS_WDN1);  gN = 1024; gK = DFF;  ekind = 2; eO = MB;  eld = D; break;
            case 13: gA = CAT; gB = (const bf16_t*)(ws + WS_W1OUT); gN = 1024; gK = 1024; ekind = 2; eO = MB;  eld = D; break;
            default: break;
        }
        if (gA && fz < 0) {
            pg8::Gemm g{gA, gB, M, gN, gK}; pg8::StaticOrder S; S.init(M, gN, G, bx);
            LAS float* rstab = (LAS float*)(lds + 131072 + 2048);
            if (tid < 256) {
                f32x4 qv[12];
#pragma unroll
                for (int i = 0; i < 12; ++i) { const int pmi = pg8::unit_pm(i, M / 256, gN / 256, G, bx); qv[i] = (f32x4){1024.f, 0.f, 0.f, 0.f}; if (pmi >= 0) qv[i] = *(const f32x4*)(SSQ + (size_t)(pmi * 256 + tid) * 4); }
#pragma unroll
                for (int i = 0; i < 12; ++i) rstab[i * 256 + tid] = 1.0f / sqrtf(((qv[i][0] + qv[i][1]) + (qv[i][2] + qv[i][3])) * (1.0f / 1024.0f) + EPS);
            }
            __syncthreads();
            pg8::EpiGen E{eO, eld, ekind, rstab};
            pg8::gemm_phase<pg8::EpiGen, pg8::StaticOrder, true, true, false>(lds, g, S, E, tid);
            continue;
        }
        if (gA) {
            const float* gpost = fz == 0 ? args.in[2] : fz == 1 ? args.in[4] : fz == 2 ? args.in[2] + D : args.in[4] + D;
            const void* xi = fz == 0 ? (const void*)x : fz == 3 ? (const void*)MB : (const void*)xo;
            void* xw = fz == 2 ? (void*)MB : (void*)xo;
            pg8::EpiFused E{xi, xw, fz == 0 ? 0 : 1, fz == 3 ? 0 : 1, gpost,
                            (float*)(ws + WS_XB + (size_t)fz * XB_BANK), (unsigned*)(ws + WS_CTL) + (size_t)fz * 128 * 64, fz == 3 ? nullptr : SSQ};
            pg8::Gemm g{gA, gB, M, gN, gK};
            const int rounds = (128 * 4 + G - 1) / G;
            for (int r = 0; r < rounds; ++r) {
                pg8::OneUnit S; S.so.init(M, gN, G, bx); S.round = r;
                pg8::gemm_phase<pg8::EpiFused, pg8::OneUnit, false, true, true>(lds, g, S, E, tid);
            }
            continue;
        }
        if (pi == 0) {
            LAS float* scr = (LAS float*)(lds + wave * 16384);
            int it = gw;
#define TR_MAT(Wp, Gp, Kk, Ns, WTp, Nd, kd) { const int items = ((Kk) / 64) * ((Nd) / 32); for (; it < items; it += 2 * ngw) p0_transpose_item2((Wp), (Gp), (Kk), (Ns), (bf16_t*)(WTp), (kd), scr, it, it + ngw < items ? it + ngw : -1, (Nd), lane); if (it - ngw >= items) it -= ngw; it -= items; }
            TR_MAT(args.in[5], args.in[1], 1024, 2560, ws + WS_W0IN, 2560, 0)
            TR_MAT(args.in[11], nullptr, 1024, 1024, ws + WS_W0OUT, 1024, 2)
            TR_MAT(args.in[19], args.in[3], 1024, 5632, ws + WS_WGU0, 5632, 1)
            TR_MAT(args.in[19] + (size_t)1024 * 5632, args.in[3] + D, 1024, 5632, ws + WS_WGU1, 5632, 1)
            TR_MAT(args.in[20], nullptr, DFF, 1024, ws + WS_WDN0, 1024, 2)
            TR_MAT(args.in[20] + (size_t)DFF * 1024, nullptr, DFF, 1024, ws + WS_WDN1, 1024, 2)
            TR_MAT(args.in[12], args.in[1] + D, 1024, 3104, ws + WS_W1IN, U1W, 3)
            TR_MAT(args.in[18], nullptr, 1024, 1024, ws + WS_W1OUT, 1024, 2)
#undef TR_MAT
            cvt_phase(x, H, SSQ, gw, ngw, lane);
            __syncthreads();
        } else if (pi == 2) {
            conv_phase(lds, UB, args.in[6], args.in[7], args.in[8], args.in[9], args.in[10], CAT, G, tid);
        } else if (pi == 7) {
            gla_phase(lds, UB, args.in[13], args.in[14], args.in[15], args.in[16], OD, G, tid);
        } else if (pi == 8) {
            gla_combine_phase(OD, UB, args.in[17], CAT, gw, ngw, lane);
        }
    }
}

extern "C" void kernel_launch(void* const* d_in, const int* in_sizes, int n_in, void* d_out, int out_size, void* d_ws, size_t ws_size, hipStream_t stream) {
    static int grid = 0;
    if (grid == 0) {
        if (n_in != 21 || out_size != M * D || ws_size < WS_END) { fprintf(stderr, "kernel_launch: unexpected problem (n_in %d out %d ws %zu)\n", n_in, out_size, ws_size); grid = -1; return; }
        int dev = 0, cus = 0, per_cu = 0;
        hipGetDevice(&dev);
        hipDeviceGetAttribute(&cus, hipDeviceAttributeMultiprocessorCount, dev);
        if (hipFuncSetAttribute((const void*)fwd_kernel, hipFuncAttributeMaxDynamicSharedMemorySize, LDS_BYTES) != hipSuccess) { fprintf(stderr, "kernel_launch: hipFuncSetAttribute failed\n"); grid = -1; return; }
        if (hipOccupancyMaxActiveBlocksPerMultiprocessor(&per_cu, (const void*)fwd_kernel, 512, LDS_BYTES) != hipSuccess || per_cu < 1) { fprintf(stderr, "kernel_launch: occupancy query gave %d\n", per_cu); per_cu = 1; }
        (void)hipGetLastError();
        grid = cus * per_cu;
    }
    if (grid < 0) return;
    if (hipMemsetAsync((char*)d_ws + WS_CTL, 0, CTL_BYTES, stream) != hipSuccess) { fprintf(stderr, "kernel_launch: memset failed\n"); return; }
    Args a{};
    for (int i = 0; i < 21; ++i) a.in[i] = (const float*)d_in[i];
    a.out = (float*)d_out; a.ws = (unsigned char*)d_ws;
#if MK_ONE_LAUNCH
#ifndef PROBE_DUP
#define PROBE_DUP -1
#endif

    { int n = 0; for (int p = 0; p < N_PHASES; ++p) { a.pl[n++] = (unsigned char)p; if (p == PROBE_DUP) a.pl[n++] = (unsigned char)p; } a.nph = n; }
#ifdef PROBE_EXTRA
    a.pl[a.nph++] = PROBE_EXTRA;
#endif
#ifdef PROBE_NULLS
    for (int i = 0; i < PROBE_NULLS; ++i) a.pl[a.nph++] = 15;
#endif
    void* kargs[] = {&a};
    hipError_t e = hipLaunchCooperativeKernel((const void*)fwd_kernel, dim3(grid), dim3(512), kargs, LDS_BYTES, stream);
    if (e != hipSuccess) fprintf(stderr, "cooperative launch failed: %s (grid %d)\n", hipGetErrorString(e), grid);
#else
    for (int p = 0; p < N_PHASES; ++p) {
        a.nph = 1; a.pl[0] = (unsigned char)p;
        hipLaunchKernelGGL(fwd_kernel, dim3(grid), dim3(512), LDS_BYTES, stream, a);
        if (p == PROBE_P) hipLaunchKernelGGL(fwd_kernel, dim3(grid), dim3(512), LDS_BYTES, stream, a);
    }
#endif
}
```

```cpp
#include <hip/hip_runtime.h>
#include <hip/hip_cooperative_groups.h>
#include <cstdio>
#include <cstdint>
namespace cg = cooperative_groups;

#ifndef MK_ONE_LAUNCH
#define MK_ONE_LAUNCH 1
#ifndef PROBE_P
#define PROBE_P -1
#endif
#endif

#define LAS __attribute__((address_space(3)))
typedef unsigned short bf16_t;
typedef short bf16x8 __attribute__((ext_vector_type(8)));
typedef float f32x4 __attribute__((ext_vector_type(4)));
typedef float f32x16 __attribute__((ext_vector_type(16)));
typedef unsigned u32x4 __attribute__((ext_vector_type(4)));
typedef unsigned u32x2 __attribute__((ext_vector_type(2)));
typedef float f32x2 __attribute__((ext_vector_type(2)));

constexpr int SEQ = 2048, NB = 16, D = 1024, M = NB * SEQ;
constexpr int DFF = 2816;
constexpr int U0W = 1536;
constexpr int U1W = 3328;
constexpr float EPS = 1e-6f;

constexpr size_t MiB = 1u << 20;
constexpr size_t WS_CTL = 0, CTL_CNT_BYTES = 8 * 128 * 64 * 4, WS_BAR = CTL_CNT_BYTES, CTL_BYTES = CTL_CNT_BYTES + 16384;
constexpr size_t WS_XB = 52 * MiB, XB_BANK = 128 * 256 * 4 * 4;
constexpr size_t WS_SSQ = 56 * MiB;
constexpr size_t WS_W0IN = 2 * MiB, WS_W0OUT = 7 * MiB, WS_WGU0 = 9 * MiB, WS_WGU1 = 20 * MiB, WS_WDN0 = 31 * MiB, WS_WDN1 = 37 * MiB,
                 WS_W1IN = 43 * MiB, WS_W1OUT = 50 * MiB;
constexpr size_t WS_H = 64 * MiB;
constexpr size_t WS_MB = 128 * MiB;
constexpr size_t WS_OD = 64 * MiB;
constexpr size_t WS_U = 192 * MiB;
constexpr size_t WS_CAT = 400 * MiB;
constexpr size_t WS_END = 464 * MiB;

constexpr int LDS_BYTES = 147456;

typedef __bf16 bf16x2_t __attribute__((ext_vector_type(2)));
__device__ __forceinline__ unsigned cvt_pk_bf16(float lo, float hi) { const f32x2 v = {lo, hi}; return __builtin_bit_cast(unsigned, __builtin_convertvector(v, bf16x2_t)); }
__device__ __forceinline__ unsigned f2bf(float f) { unsigned u = __builtin_bit_cast(unsigned, f); return (u + 0x7fffu + ((u >> 16) & 1u)) >> 16; }
__device__ __forceinline__ float bf2f(unsigned b) { return __builtin_bit_cast(float, b << 16); }
__device__ __forceinline__ float bflo(unsigned w) { return __builtin_bit_cast(float, w << 16); }
__device__ __forceinline__ float bfhi(unsigned w) { return __builtin_bit_cast(float, w & 0xffff0000u); }
__device__ __forceinline__ float sigmoidf_(float x) { return __builtin_amdgcn_rcpf(1.0f + __expf(-x)); }
#define DPP_F(v, ctrl) __builtin_bit_cast(float, __builtin_amdgcn_update_dpp(0, __builtin_bit_cast(int, (v)), (ctrl), 0xF, 0xF, true))
__device__ __forceinline__ float row16_sum(float v) { v += DPP_F(v, 0xB1); v += DPP_F(v, 0x4E); v += DPP_F(v, 0x141); v += DPP_F(v, 0x140); return v; }
__device__ __forceinline__ float wave_sum(float v) {
    v = row16_sum(v);
    const float a = __builtin_bit_cast(float, __builtin_amdgcn_readlane(__builtin_bit_cast(int, v), 0)), b = __builtin_bit_cast(float, __builtin_amdgcn_readlane(__builtin_bit_cast(int, v), 16)),
                c = __builtin_bit_cast(float, __builtin_amdgcn_readlane(__builtin_bit_cast(int, v), 32)), d = __builtin_bit_cast(float, __builtin_amdgcn_readlane(__builtin_bit_cast(int, v), 48));
    return (a + b) + (c + d);
}

namespace pg8 {
#define PG8_LAS __attribute__((address_space(3)))
constexpr int BM = 256, BK = 64, HALF = 128, HTB = HALF * BK * 2, STAGE_BYTES = 8 * HTB, NXCD = 8, WGM = 8;
__host__ __device__ __forceinline__ int lds_byte(int r, int c) { const int st = (r >> 4) * 2 + (c >> 5), rr = r & 15, cc = c & 31, ob = rr * 64 + cc * 2; return st * 1024 + (ob ^ (((ob >> 9) & 1) << 5)); }
__host__ __device__ __forceinline__ void stage_rc(int b, int& R, int& C) { const int st = b / 1024, sb = b % 1024, swz = sb ^ (((sb >> 9) & 1) << 5); R = (st >> 1) * 16 + swz / 64; C = (st & 1) * 32 + (swz % 64) / 2; }
__host__ __device__ __forceinline__ int perm32(int rho) { const int n = rho >> 4, i = rho & 15; return 8 * (i >> 2) + 4 * n + (i & 3); }

struct Unit { int pm, pn; };
__device__ __forceinline__ int unit_pm(int i, int nM, int nN, int G, int c) {
    const int nwg = nM * nN; const long L = (long)i * G + c; if (L >= nwg) return -1;
    int wgid = (int)L; { const int q = nwg / 8, r = nwg % 8, xcd = wgid % 8, off = wgid / 8; wgid = (xcd < r ? xcd * (q + 1) : r * (q + 1) + (xcd - r) * q) + off; }
    const int nig = 8 * nN, gid = wgid / nig, fm = gid * 8, gsz = (nM - fm) < 8 ? (nM - fm) : 8;
    return fm + ((wgid % nig) % gsz);
}

struct Gemm { const bf16_t* A; const bf16_t* Bt; int M, N, K; };

struct StaticOrder {
    int nM, nN, nwg, G, c;
    __host__ __device__ void init(int M_, int N_, int G_, int c_) { nM = M_ / BM; nN = N_ / BM; nwg = nM * nN; G = G_; c = c_; }
    __host__ __device__ bool next(int i, Unit& u) const {
        const long L = (long)i * G + c; if (L >= nwg) return false;
        int wgid = (int)L; { const int q = nwg / NXCD, r = nwg % NXCD, xcd = wgid % NXCD, off = wgid / NXCD; wgid = (xcd < r ? xcd * (q + 1) : r * (q + 1) + (xcd - r) * q) + off; }
        const int nig = WGM * nN, gid = wgid / nig, fm = gid * WGM, gsz = (nM - fm) < WGM ? (nM - fm) : WGM;
        u.pm = fm + ((wgid % nig) % gsz); u.pn = (wgid % nig) / gsz; return true;
    }
    __host__ __device__ int pm_of(int i) const {
        const long L = (long)i * G + c; if (L >= nwg) return -1;
        int wgid = (int)L; { const int q = nwg / NXCD, r = nwg % NXCD, xcd = wgid % NXCD, off = wgid / NXCD; wgid = (xcd < r ? xcd * (q + 1) : r * (q + 1) + (xcd - r) * q) + off; }
        const int nig = WGM * nN, gid = wgid / nig, fm = gid * WGM, gsz = (nM - fm) < WGM ? (nM - fm) : WGM;
        return fm + ((wgid % nig) % gsz);
    }
};

struct EpiGen {
    static constexpr bool PERM = true;
    bf16_t* O; int ldc; int kind; const PG8_LAS float* rstab;
    __device__ __forceinline__ void operator()(const f32x4 (&acc)[2][2][4][2], const Unit& u, int wr, int wc, int fr, int fq, int ui) const {
        const int row0 = u.pm * BM + wr * 64 + fr;
        const PG8_LAS float* rst = rstab + ui * 256 + wr * 64 + fr;
        const int cw = wc * 32 + 8 * fq;
        int mode = 0, colbase = u.pn * BM;
        if (kind == 0) { if (u.pn < 4) { mode = 1; colbase = u.pn * 128; } else if (u.pn < 8) { mode = 2; colbase = 512 + (u.pn - 4) * 128; } else { colbase = 1024 + (u.pn - 8) * 256; } }
        else if (kind == 1) { mode = 3; colbase = u.pn * 128; }
        if (mode == 0) {
#pragma unroll
            for (int ai = 0; ai < 2; ++ai)
#pragma unroll
                for (int m = 0; m < 4; ++m) {
                    const int row = row0 + ai * HALF + m * 16;
                    bf16_t* rowp = O + (size_t)row * ldc + colbase + cw;
                    const float rs = rst[ai * HALF + m * 16];
#pragma unroll
                    for (int bj = 0; bj < 2; ++bj) { const f32x4 v0 = acc[ai][bj][m][0] * rs, v1 = acc[ai][bj][m][1] * rs;
                        u32x4 w; w.x = cvt_pk_bf16(v0[0], v0[1]); w.y = cvt_pk_bf16(v0[2], v0[3]); w.z = cvt_pk_bf16(v1[0], v1[1]); w.w = cvt_pk_bf16(v1[2], v1[3]);
                        *(u32x4*)(rowp + bj * HALF) = w; }
                }
        } else if (mode == 1) gated<1>(acc, rst, O + (size_t)row0 * ldc + colbase + cw);
        else if (mode == 2) gated<2>(acc, rst, O + (size_t)row0 * ldc + colbase + cw);
        else gated<3>(acc, rst, O + (size_t)row0 * ldc + colbase + cw);
    }
    template <int MODE> __device__ __forceinline__ void gated(const f32x4 (&acc)[2][2][4][2], const PG8_LAS float* rst, bf16_t* base) const {
#pragma unroll
        for (int ai = 0; ai < 2; ++ai)
#pragma unroll
            for (int m = 0; m < 4; ++m) {
                const float rs = rst[ai * HALF + m * 16]; const float rs2 = rs * rs, nrl = rs * -1.4426950408889634f;
                unsigned w[4];
#pragma unroll
                for (int n = 0; n < 2; ++n)
#pragma unroll
                    for (int h = 0; h < 2; ++h) {
                        const f32x2 a = {acc[ai][0][m][n][2 * h], acc[ai][0][m][n][2 * h + 1]}, b = {acc[ai][1][m][n][2 * h], acc[ai][1][m][n][2 * h + 1]};
                        f32x2 o = (a * b) * rs2;
                        if (MODE != 2) { const f32x2 t = (MODE == 1 ? b : a) * nrl; f32x2 d; d.x = __builtin_amdgcn_exp2f(t.x); d.y = __builtin_amdgcn_exp2f(t.y); d = d + 1.0f;
                            f32x2 r; r.x = __builtin_amdgcn_rcpf(d.x); r.y = __builtin_amdgcn_rcpf(d.y);
                            o = MODE == 1 ? (a * rs) * r : o * r; }
                        w[n * 2 + h] = cvt_pk_bf16(o.x, o.y);
                    }
                *(u32x4*)(base + (size_t)(ai * HALF + m * 16) * ldc) = (u32x4){w[0], w[1], w[2], w[3]};
            }
    }
};

struct OneUnit { StaticOrder so; int round;
    __device__ __forceinline__ bool next(int i, Unit& u) const { return i == 0 ? so.next(round, u) : false; } };

__device__ __forceinline__ void panel_rstd(const f32x4 (&v)[2][2][4][2], const Unit& u, int wr, int wc, int fr, int fq, PG8_LAS unsigned char* lds, int wid, int lane, float* xbuf, unsigned* cnt) {
    PG8_LAS float* P = (PG8_LAS float*)lds;
    PG8_LAS float* S = (PG8_LAS float*)(lds + 8192);
#pragma unroll
    for (int ai = 0; ai < 2; ++ai)
#pragma unroll
        for (int m = 0; m < 4; ++m) {
            float s = 0.f;
#pragma unroll
            for (int bj = 0; bj < 2; ++bj)
#pragma unroll
                for (int n = 0; n < 2; ++n) { const f32x4 x = v[ai][bj][m][n]; s += (x[0] * x[0] + x[1] * x[1]) + (x[2] * x[2] + x[3] * x[3]); }
            s += __shfl_xor(s, 16); s += __shfl_xor(s, 32);
            if (fq == 0) P[(ai * HALF + wr * 64 + m * 16 + fr) * 4 + wc] = s;
        }
    asm volatile("s_waitcnt lgkmcnt(0)" ::: "memory"); __builtin_amdgcn_s_barrier(); asm volatile("" ::: "memory");
    const int row = wid * 32 + (lane & 31);
    if (lane < 32) {
        const f32x4 p = *(const PG8_LAS f32x4*)(P + row * 4);
        const float t = (p[0] + p[1]) + (p[2] + p[3]);
        __hip_atomic_store((unsigned*)xbuf + ((size_t)(u.pm * BM + row) * 4 + u.pn), __builtin_bit_cast(unsigned, t), __ATOMIC_RELAXED, __HIP_MEMORY_SCOPE_AGENT);
    }
    asm volatile("s_waitcnt vmcnt(0)" ::: "memory");
    if (lane == 0) __hip_atomic_fetch_add(cnt + 64 * u.pm, 1u, __ATOMIC_RELAXED, __HIP_MEMORY_SCOPE_AGENT);
    if (wid == 0) {
        unsigned spins = 0;
        while ((unsigned)__builtin_amdgcn_readfirstlane(__hip_atomic_load(cnt + 64 * u.pm, __ATOMIC_RELAXED, __HIP_MEMORY_SCOPE_AGENT)) < 32u) { __builtin_amdgcn_s_sleep(2); if (++spins > (1u << 22)) break; }
        __builtin_amdgcn_fence(__ATOMIC_ACQUIRE, "agent");
    }
    asm volatile("s_waitcnt vmcnt(0) lgkmcnt(0)" ::: "memory"); __builtin_amdgcn_s_barrier(); asm volatile("" ::: "memory");
    if (lane < 32) {
        const unsigned* slot = (const unsigned*)xbuf + (size_t)(u.pm * BM + row) * 4; float tot = 0.f;
#pragma unroll
        for (int t = 0; t < 4; ++t) tot += __builtin_bit_cast(float, __hip_atomic_load(slot + t, __ATOMIC_RELAXED, __HIP_MEMORY_SCOPE_AGENT));
        S[row] = 1.0f / sqrtf(tot * (1.0f / 1024.0f) + 1e-6f);
    }
    asm volatile("s_waitcnt lgkmcnt(0)" ::: "memory"); __builtin_amdgcn_s_barrier(); asm volatile("" ::: "memory");
}

struct EpiFused {
    static constexpr bool PERM = true;
    const void* xin; void* xout; int in_bf, out_bf; const float* gpost; float* xb1; unsigned* cnt1; float* ssq;
    __device__ __forceinline__ void operator()(const f32x4 (&)[2][2][4][2], const Unit&, int, int, int, int, int) const {}
    __device__ __forceinline__ void fused(f32x4 (&acc)[2][2][4][2], const Unit& u, int wr, int wc, int fr, int fq, PG8_LAS unsigned char* lds, int wid, int lane) const {
        PG8_LAS float* P = (PG8_LAS float*)lds;
        const PG8_LAS float* S = (const PG8_LAS float*)(lds + 8192);
        const int col0 = u.pn * BM + wc * 32 + 8 * fq;
        u32x4 xw[4][2];
        if (in_bf) {
#pragma unroll
            for (int m = 0; m < 4; ++m)
#pragma unroll
                for (int bj = 0; bj < 2; ++bj) xw[m][bj] = *(const u32x4*)((const bf16_t*)xin + (size_t)(u.pm * BM + wr * 64 + m * 16 + fr) * 1024 + col0 + bj * HALF);
        }
        panel_rstd(acc, u, wr, wc, fr, fq, lds, wid, lane, xb1, cnt1);
        f32x4 g[2][2];
#pragma unroll
        for (int bj = 0; bj < 2; ++bj)
#pragma unroll
            for (int n = 0; n < 2; ++n) g[bj][n] = *(const f32x4*)(gpost + col0 + bj * HALF + 4 * n);
#pragma unroll
        for (int ai = 0; ai < 2; ++ai)
#pragma unroll
            for (int m = 0; m < 4; ++m) { const int r = ai * HALF + wr * 64 + m * 16 + fr; const float rs = S[r]; const size_t off = (size_t)(u.pm * BM + r) * 1024 + col0;
                float sq = 0.f;
#pragma unroll
                for (int bj = 0; bj < 2; ++bj) {
                    f32x4 b0, b1;
                    if (in_bf) { const u32x4 w = ai == 0 ? xw[m][bj] : *(const u32x4*)((const bf16_t*)xin + off + bj * HALF); b0 = (f32x4){bflo(w.x), bfhi(w.x), bflo(w.y), bfhi(w.y)}; b1 = (f32x4){bflo(w.z), bfhi(w.z), bflo(w.w), bfhi(w.w)}; }
                    else { b0 = *(const f32x4*)((const float*)xin + off + bj * HALF); b1 = *(const f32x4*)((const float*)xin + off + bj * HALF + 4); }
                    const f32x4 o0 = b0 + acc[ai][bj][m][0] * rs * g[bj][0], o1 = b1 + acc[ai][bj][m][1] * rs * g[bj][1];
                    sq += (o0[0] * o0[0] + o0[1] * o0[1]) + (o0[2] * o0[2] + o0[3] * o0[3]) + (o1[0] * o1[0] + o1[1] * o1[1]) + (o1[2] * o1[2] + o1[3] * o1[3]);
                    if (out_bf) { u32x4 w; w.x = cvt_pk_bf16(o0[0], o0[1]); w.y = cvt_pk_bf16(o0[2], o0[3]); w.z = cvt_pk_bf16(o1[0], o1[1]); w.w = cvt_pk_bf16(o1[2], o1[3]); *(u32x4*)((bf16_t*)xout + off + bj * HALF) = w; }
                    else { *(f32x4*)((float*)xout + off + bj * HALF) = o0; *(f32x4*)((float*)xout + off + bj * HALF + 4) = o1; } }
                sq += __shfl_xor(sq, 16); sq += __shfl_xor(sq, 32);
                if (fq == 0) P[r * 4 + wc] = sq;
                if (m & 1) asm volatile("" ::: "memory"); }
        asm volatile("s_waitcnt lgkmcnt(0)" ::: "memory"); __builtin_amdgcn_s_barrier(); asm volatile("" ::: "memory");
        if (ssq && lane < 32) { const int row = wid * 32 + lane; const f32x4 p = *(const PG8_LAS f32x4*)(P + row * 4); ssq[(size_t)(u.pm * BM + row) * 4 + u.pn] = (p[0] + p[1]) + (p[2] + p[3]); }
        asm volatile("s_waitcnt lgkmcnt(0)" ::: "memory"); __builtin_amdgcn_s_barrier(); asm volatile("" ::: "memory");
    }
};

template <class Epi, class Sched, bool ALIGN_EPI, bool SP2, bool FUSED>
__device__ __forceinline__ void gemm_phase(PG8_LAS unsigned char* lds, const Gemm g, const Sched& S, const Epi& E, const int tid) {
    const int wid = __builtin_amdgcn_readfirstlane(tid >> 6), lane = tid & 63, wr = wid >> 2, wc = wid & 3, fr = lane & 15, fq = lane >> 4;
    const int K = g.K, nt = K / BK;
    unsigned voffA[2], voffB[2];
#pragma unroll
    for (int i = 0; i < 2; ++i) { int R, C; stage_rc(tid * 16 + i * 8192, R, C); const int Rb = Epi::PERM ? ((R & ~31) + perm32(R & 31)) : R;
        voffA[i] = (unsigned)(R * K + C) * 2u; voffB[i] = (unsigned)(Rb * K + C) * 2u; }
    const size_t kstep = (size_t)(BK * 2);
    const size_t hstep = (size_t)HALF * K * 2;
    const size_t tstep = 2 * hstep;
    const unsigned ldsw = (unsigned)wid * 1024u;
    const int aoff = lds_byte(wr * 64 + fr, fq * 8), boff = lds_byte(wc * 32 + fr, fq * 8);
#define PG8_SA(b, h) (((b) * 2 + (h)) * HTB)
#define PG8_SB(b, h) ((4 + (b) * 2 + (h)) * HTB)
#define PG8_STAGE(bufoff, gbase, voff) do { _Pragma("unroll") for (int _i = 0; _i < 2; ++_i) \
        __builtin_amdgcn_global_load_lds((const unsigned*)((const char*)(gbase) + (voff)[_i]), (PG8_LAS unsigned*)(lds + (bufoff) + ldsw + _i * 8192), 16, 0, 0); } while (0)
#define PG8_LDA(dst, b, h) do { _Pragma("unroll") for (int m = 0; m < 4; ++m) _Pragma("unroll") for (int k = 0; k < 2; ++k) dst[m][k] = *(const PG8_LAS bf16x8*)(lds + PG8_SA(b, h) + aoff + m * 2048 + k * 1024); } while (0)
#define PG8_LDB(dst, b, h) do { _Pragma("unroll") for (int n = 0; n < 2; ++n) _Pragma("unroll") for (int k = 0; k < 2; ++k) dst[n][k] = *(const PG8_LAS bf16x8*)(lds + PG8_SB(b, h) + boff + n * 2048 + k * 1024); } while (0)
#define PG8_MMA(ai, bj, At, Bt) do { __builtin_amdgcn_s_setprio(1); _Pragma("unroll") for (int m = 0; m < 4; ++m) _Pragma("unroll") for (int n = 0; n < 2; ++n) _Pragma("unroll") for (int k = 0; k < 2; ++k) \
        acc[ai][bj][m][n] = __builtin_amdgcn_mfma_f32_16x16x32_bf16(Bt[n][k], At[m][k], acc[ai][bj][m][n], 0, 0, 0); __builtin_amdgcn_s_setprio(0); } while (0)
#define PG8_WAIT_V(n) asm volatile("s_waitcnt vmcnt(" #n ")" ::: "memory")
#define PG8_WAIT_L(n) asm volatile("s_waitcnt lgkmcnt(" #n ")" ::: "memory")
#define PG8_BAR __builtin_amdgcn_s_barrier()
#define PG8_SCHED __builtin_amdgcn_sched_barrier(0)
    Unit cur, nxt; int ui = 0;
    if (!S.next(0, cur)) return;
    f32x4 acc[2][2][4][2];
#pragma unroll
    for (int a = 0; a < 2; ++a)
#pragma unroll
        for (int b = 0; b < 2; ++b)
#pragma unroll
            for (int m = 0; m < 4; ++m)
#pragma unroll
                for (int n = 0; n < 2; ++n) acc[a][b][m][n] = (f32x4){0.f, 0.f, 0.f, 0.f};
    bf16x8 At[4][2], B0[2][2], B1[2][2];
    const char* cA = (const char*)g.A + (size_t)cur.pm * tstep; const char* cB = (const char*)g.Bt + (size_t)cur.pn * tstep;
    if constexpr (SP2) {
        PG8_STAGE(PG8_SB(0, 0), cB, voffB); PG8_STAGE(PG8_SB(0, 1), cB + hstep, voffB); PG8_STAGE(PG8_SA(0, 0), cA, voffA); PG8_STAGE(PG8_SA(0, 1), cA + hstep, voffA);
        if (wr == 1) PG8_BAR;
        PG8_WAIT_V(2); PG8_BAR;
        PG8_STAGE(PG8_SB(1, 0), cB + kstep, voffB); PG8_STAGE(PG8_SA(1, 0), cA + kstep, voffA); PG8_STAGE(PG8_SB(1, 1), cB + hstep + kstep, voffB);
        PG8_WAIT_V(6); PG8_BAR;
    } else {
        PG8_STAGE(PG8_SB(0, 0), cB, voffB); PG8_STAGE(PG8_SA(0, 0), cA, voffA); PG8_STAGE(PG8_SB(0, 1), cB + hstep, voffB); PG8_STAGE(PG8_SA(0, 1), cA + hstep, voffA);
        if (wr == 1) PG8_BAR;
        PG8_WAIT_V(4); PG8_BAR;
        PG8_STAGE(PG8_SB(1, 0), cB + kstep, voffB); PG8_STAGE(PG8_SA(1, 0), cA + kstep, voffA); PG8_STAGE(PG8_SB(1, 1), cB + hstep + kstep, voffB);
        PG8_WAIT_V(6); PG8_BAR;
    }
    for (;;) {
        const bool has_next = S.next(ui + 1, nxt);
        const char* nA = has_next ? (const char*)g.A + (size_t)nxt.pm * tstep : cA; const char* nB = has_next ? (const char*)g.Bt + (size_t)nxt.pn * tstep : cB;
        for (int t = 0; t < nt; t += 2) {
            const bool last = (t == nt - 2);
            const char* a1 = cA + (size_t)(t + 1) * kstep;
            const char* a2 = last ? nA : cA + (size_t)(t + 2) * kstep; const char* b2 = last ? nB : cB + (size_t)(t + 2) * kstep;
            const char* a3 = a2 + kstep; const char* b3 = b2 + kstep;
            if constexpr (SP2) {
            PG8_LDB(B0, 0, 0); PG8_LDB(B1, 0, 1); PG8_SCHED; PG8_LDA(At, 0, 0); PG8_STAGE(PG8_SA(1, 1), a1 + hstep, voffA);
            PG8_WAIT_V(8); PG8_WAIT_L(0); PG8_BAR; PG8_MMA(0, 0, At, B0); PG8_MMA(0, 1, At, B1); PG8_BAR; PG8_SCHED;
            PG8_LDA(At, 0, 1); PG8_STAGE(PG8_SB(0, 0), b2, voffB); PG8_STAGE(PG8_SB(0, 1), b2 + hstep, voffB); PG8_STAGE(PG8_SA(0, 0), a2, voffA);
            PG8_WAIT_V(8); PG8_WAIT_L(0); PG8_BAR; PG8_MMA(1, 0, At, B0); PG8_MMA(1, 1, At, B1); PG8_BAR; PG8_SCHED;
            PG8_LDB(B0, 1, 0); PG8_LDB(B1, 1, 1); PG8_SCHED; PG8_LDA(At, 1, 0); PG8_STAGE(PG8_SA(0, 1), a2 + hstep, voffA);
            PG8_WAIT_V(8); PG8_WAIT_L(0); PG8_BAR; PG8_MMA(0, 0, At, B0); PG8_MMA(0, 1, At, B1); PG8_BAR; PG8_SCHED;
            PG8_LDA(At, 1, 1); PG8_STAGE(PG8_SB(1, 0), b3, voffB); PG8_STAGE(PG8_SB(1, 1), b3 + hstep, voffB); PG8_STAGE(PG8_SA(1, 0), a3, voffA);
            PG8_WAIT_V(8); PG8_WAIT_L(0); PG8_BAR; PG8_MMA(1, 0, At, B0); PG8_MMA(1, 1, At, B1); PG8_BAR; PG8_SCHED;
            } else {
            PG8_LDB(B0, 0, 0); PG8_SCHED; PG8_LDA(At, 0, 0); PG8_STAGE(PG8_SA(1, 1), a1 + hstep, voffA);
            PG8_WAIT_L(8); PG8_BAR; PG8_WAIT_L(0); PG8_MMA(0, 0, At, B0); PG8_BAR; PG8_SCHED;
            PG8_LDB(B1, 0, 1); PG8_STAGE(PG8_SB(0, 0), b2, voffB);
            PG8_BAR; PG8_WAIT_L(0); PG8_MMA(0, 1, At, B1); PG8_BAR;
            PG8_LDA(At, 0, 1); PG8_STAGE(PG8_SA(0, 0), a2, voffA);
            PG8_BAR; PG8_WAIT_L(0); PG8_MMA(1, 0, At, B0); PG8_BAR; PG8_SCHED;
            PG8_STAGE(PG8_SB(0, 1), b2 + hstep, voffB);
            PG8_WAIT_V(6); PG8_BAR; PG8_MMA(1, 1, At, B1); PG8_BAR;
            PG8_LDB(B0, 1, 0); PG8_SCHED; PG8_LDA(At, 1, 0); PG8_STAGE(PG8_SA(0, 1), a2 + hstep, voffA);
            PG8_WAIT_L(8); PG8_BAR; PG8_WAIT_L(0); PG8_MMA(0, 0, At, B0); PG8_BAR; PG8_SCHED;
            PG8_LDB(B1, 1, 1); PG8_STAGE(PG8_SB(1, 0), b3, voffB);
            PG8_BAR; PG8_WAIT_L(0); PG8_MMA(0, 1, At, B1); PG8_BAR;
            PG8_LDA(At, 1, 1); PG8_STAGE(PG8_SA(1, 0), a3, voffA);
            PG8_BAR; PG8_WAIT_L(0); PG8_MMA(1, 0, At, B0); PG8_BAR; PG8_SCHED;
            PG8_STAGE(PG8_SB(1, 1), b3 + hstep, voffB);
            PG8_WAIT_V(6); PG8_BAR; PG8_MMA(1, 1, At, B1); PG8_BAR;
            }
        }
        if constexpr (ALIGN_EPI) { if (wr == 0) PG8_BAR; }
        if constexpr (!FUSED) E(acc, cur, wr, wc, fr, fq, ui);
        if (!has_next) break;
#pragma unroll
        for (int a = 0; a < 2; ++a)
#pragma unroll
            for (int b = 0; b < 2; ++b)
#pragma unroll
                for (int m = 0; m < 4; ++m)
#pragma unroll
                    for (int n = 0; n < 2; ++n) acc[a][b][m][n] = (f32x4){0.f, 0.f, 0.f, 0.f};
        cur = nxt; cA = nA; cB = nB; ++ui;
        if constexpr (ALIGN_EPI) { if (wr == 1) PG8_BAR; }
    }
    PG8_WAIT_V(0);
    if constexpr (!ALIGN_EPI) { if (wr == 0) PG8_BAR; }
    PG8_BAR;
    if constexpr (FUSED) E.fused(acc, cur, wr, wc, fr, fq, lds, wid, lane);
#undef PG8_SA
#undef PG8_SB
#undef PG8_STAGE
#undef PG8_LDA
#undef PG8_LDB
#undef PG8_MMA
#undef PG8_WAIT_V
#undef PG8_WAIT_L
#undef PG8_BAR
#undef PG8_SCHED
}
}

__device__ __forceinline__ int srccol(int kind, int n0, int nsrc) {
    if (kind == 0) { const int t = n0 >> 8, w = n0 & 255, bj = w >> 7, j = w & 127;
        if (t < 4) return bj == 0 ? 128 * t + j : 512 + 128 * t + j;
        if (t < 8) return bj == 0 ? 1536 + 128 * (t - 4) + j : 2048 + 128 * (t - 4) + j;
        return 1024 + 256 * (t - 8) + w; }
    if (kind == 1) { const int pn = n0 >> 8, w = n0 & 255, bj = w >> 7, j = w & 127; return bj * DFF + 128 * pn + j; }
    return n0 < nsrc ? n0 : -1;
}
__device__ __forceinline__ void p0_tr_load(const float* W, const float* gk, int K, int N, int kind, int item, int ndst, int lane, float (&tmp)[32], int& k0, int& n0) {
    const int nblk = ndst / 32, kb = item / nblk, nb = item % nblk; k0 = 64 * kb; n0 = 32 * nb;
    const int sc = srccol(kind, n0, N);
    const float wsc = (kind == 3 && n0 < 512) ? 0.08838834764831845f : 1.0f;
#pragma unroll
    for (int i = 0; i < 32; ++i) { const int kk = 2 * i + (lane >> 5); tmp[i] = sc >= 0 ? W[(size_t)(k0 + kk) * N + sc + (lane & 31)] * (gk ? gk[k0 + kk] * wsc : wsc) : 0.f; }
}
__device__ __forceinline__ void p0_tr_store(int K, bf16_t* WT, LAS float* scr, int lane, const float (&tmp)[32], int k0, int n0) {
#pragma unroll
    for (int i = 0; i < 32; ++i) { const int kk = 2 * i + (lane >> 5); scr[kk * 33 + (lane & 31)] = tmp[i]; }
    asm volatile("s_waitcnt lgkmcnt(0)" ::: "memory");
    const int c = lane & 7;
#pragma unroll
    for (int j = 0; j < 4; ++j) { const int n = (lane >> 3) + 8 * j; const LAS float* sp = scr + (8 * c) * 33 + n;
        u32x4 o; o.x = cvt_pk_bf16(sp[0 * 33], sp[1 * 33]); o.y = cvt_pk_bf16(sp[2 * 33], sp[3 * 33]); o.z = cvt_pk_bf16(sp[4 * 33], sp[5 * 33]); o.w = cvt_pk_bf16(sp[6 * 33], sp[7 * 33]);
        *(u32x4*)(WT + (size_t)(n0 + n) * K + k0 + 8 * c) = o; }
    asm volatile("s_waitcnt lgkmcnt(0)" ::: "memory");
}
__device__ __forceinline__ void p0_transpose_item2(const float* W, const float* gk, int K, int N, bf16_t* WT, int kind, LAS float* scr, int item, int item2, int ndst, int lane) {
    float ta[32], tb[32]; int k0a, n0a, k0b = 0, n0b = 0;
    p0_tr_load(W, gk, K, N, kind, item, ndst, lane, ta, k0a, n0a);
    if (item2 >= 0) p0_tr_load(W, gk, K, N, kind, item2, ndst, lane, tb, k0b, n0b);
    p0_tr_store(K, WT, scr, lane, ta, k0a, n0a);
    if (item2 >= 0) p0_tr_store(K, WT, scr, lane, tb, k0b, n0b);
}

__device__ __forceinline__ void norm_phase(const float* xin, const bf16_t* mb, const float* ss, const float* gpost, const float* gpre, float* xout, bf16_t* h, int gw, int ngw, int lane) {
    for (int row0 = gw; row0 < M; row0 += 2 * ngw) {
        const bool two = row0 + ngw < M;
        f32x4 v[2][4]; u32x2 mw[2][4]; float sv[2];
#pragma unroll
        for (int r = 0; r < 2; ++r) { if (r == 1 && !two) break; const int row = row0 + r * ngw;
            const f32x4* xr = (const f32x4*)(xin + (size_t)row * D) + lane;
#pragma unroll
            for (int j = 0; j < 4; ++j) v[r][j] = xr[64 * j];
            if (mb) { sv[r] = ss[(size_t)row * 16 + (lane & 15)]; const u32x2* mr = (const u32x2*)(mb + (size_t)row * D) + lane;
#pragma unroll
                for (int j = 0; j < 4; ++j) mw[r][j] = mr[64 * j]; } }
#pragma unroll
        for (int r = 0; r < 2; ++r) { if (r == 1 && !two) break; const int row = row0 + r * ngw;
            if (mb) {
                const float rs = 1.0f / sqrtf(row16_sum(sv[r]) * (1.0f / D) + EPS);
#pragma unroll
                for (int j = 0; j < 4; ++j) { const u32x2 w = mw[r][j]; const f32x4 g = ((const f32x4*)gpost)[64 * j + lane];
                    v[r][j][0] += bflo(w.x) * rs * g[0]; v[r][j][1] += bfhi(w.x) * rs * g[1]; v[r][j][2] += bflo(w.y) * rs * g[2]; v[r][j][3] += bfhi(w.y) * rs * g[3]; }
            }
            if (xout) { f32x4* xo = (f32x4*)(xout + (size_t)row * D) + lane;
#pragma unroll
                for (int j = 0; j < 4; ++j) xo[64 * j] = v[r][j]; }
            if (h) {
                float s2 = 0.f;
#pragma unroll
                for (int j = 0; j < 4; ++j) s2 += (v[r][j][0] * v[r][j][0] + v[r][j][1] * v[r][j][1]) + (v[r][j][2] * v[r][j][2] + v[r][j][3] * v[r][j][3]);
                const float rs = 1.0f / sqrtf(wave_sum(s2) * (1.0f / D) + EPS);
                u32x2* ho = (u32x2*)(h + (size_t)row * D) + lane;
#pragma unroll
                for (int j = 0; j < 4; ++j) { const f32x4 g = ((const f32x4*)gpre)[64 * j + lane]; u32x2 w; w.x = cvt_pk_bf16(v[r][j][0] * rs * g[0], v[r][j][1] * rs * g[1]); w.y = cvt_pk_bf16(v[r][j][2] * rs * g[2], v[r][j][3] * rs * g[3]); ho[64 * j] = w; }
            }
        }
    }
}

__device__ __forceinline__ void cvt_phase(const float* xin, bf16_t* xb, float* ssq, int gw, int ngw, int lane) {
    constexpr int R = 4;
    for (int row0 = gw; row0 < M; row0 += R * ngw) {
        f32x4 v[R][4];
#pragma unroll
        for (int r = 0; r < R; ++r) { if (row0 + r * ngw >= M) break; const f32x4* xr = (const f32x4*)(xin + (size_t)(row0 + r * ngw) * D) + lane;
#pragma unroll
            for (int j = 0; j < 4; ++j) v[r][j] = __builtin_nontemporal_load(xr + 64 * j); }
#pragma unroll
        for (int r = 0; r < R; ++r) { const int row = row0 + r * ngw; if (row >= M) break;
            float s2 = 0.f; u32x2* ho = (u32x2*)(xb + (size_t)row * D) + lane;
#pragma unroll
            for (int j = 0; j < 4; ++j) { s2 += (v[r][j][0] * v[r][j][0] + v[r][j][1] * v[r][j][1]) + (v[r][j][2] * v[r][j][2] + v[r][j][3] * v[r][j][3]);
                u32x2 w; w.x = cvt_pk_bf16(v[r][j][0], v[r][j][1]); w.y = cvt_pk_bf16(v[r][j][2], v[r][j][3]); ho[64 * j] = w; }
            s2 = wave_sum(s2);
            if (lane == 0) *(f32x4*)(ssq + (size_t)row * 4) = (f32x4){s2, 0.f, 0.f, 0.f};
        }
    }
}

__device__ __forceinline__ void gla_combine_phase(const bf16_t* od, const bf16_t* u1, const float* gn, bf16_t* og, int gw, int ngw, int lane) {
    for (int row0 = gw; row0 < M; row0 += 2 * ngw) {
        const bool two = row0 + ngw < M;
        u32x2 wa[2][4], wb[2][4], wr_[2][4];
#pragma unroll
        for (int r = 0; r < 2; ++r) { if (r == 1 && !two) break; const int row = row0 + r * ngw;
            const u32x2* a = (const u32x2*)(od + (size_t)row * D) + lane;
            const u32x2* b = (const u32x2*)(od + (size_t)M * D + (size_t)row * D) + lane;
            const u32x2* rr = (const u32x2*)(u1 + (size_t)row * U1W + 2048) + lane;
#pragma unroll
            for (int j = 0; j < 4; ++j) { wa[r][j] = a[64 * j]; wb[r][j] = b[64 * j]; wr_[r][j] = rr[64 * j]; } }
#pragma unroll
        for (int r = 0; r < 2; ++r) { if (r == 1 && !two) break; const int row = row0 + r * ngw;
            u32x2* o = (u32x2*)(og + (size_t)row * D) + lane;
#pragma unroll
            for (int j = 0; j < 4; ++j) {
                const f32x4 g = ((const f32x4*)gn)[64 * j + lane];
                float v0 = bflo(wa[r][j].x) + bflo(wb[r][j].x), v1 = bfhi(wa[r][j].x) + bfhi(wb[r][j].x), v2 = bflo(wa[r][j].y) + bflo(wb[r][j].y), v3 = bfhi(wa[r][j].y) + bfhi(wb[r][j].y);
                const float s = wave_sum((v0 * v0 + v1 * v1) + (v2 * v2 + v3 * v3));
                const float rs = 1.0f / sqrtf(s * (1.0f / 256.0f) + EPS);
                const float r0 = bflo(wr_[r][j].x), r1 = bfhi(wr_[r][j].x), r2 = bflo(wr_[r][j].y), r3 = bfhi(wr_[r][j].y);
                v0 = v0 * rs * g[0] * (r0 * sigmoidf_(r0)); v1 = v1 * rs * g[1] * (r1 * sigmoidf_(r1)); v2 = v2 * rs * g[2] * (r2 * sigmoidf_(r2)); v3 = v3 * rs * g[3] * (r3 * sigmoidf_(r3));
                u32x2 w; w.x = cvt_pk_bf16(v0, v1); w.y = cvt_pk_bf16(v2, v3); o[64 * j] = w;
            }
        }
    }
}

constexpr int CT = 32;
constexpr int CV_IN_ROWS = CT + 30;
constexpr int CV_OUT_OFF = CV_IN_ROWS * 1024;
__device__ __forceinline__ void conv_phase(LAS unsigned char* lds, const bf16_t* U0, const float* dw_w, const float* dw_b, const float* ln_g, const float* ln_b, const float* sc_w, bf16_t* CAT, int G, const int tid) {
    const int wid = tid >> 6, lane = tid & 63;
    const int p = tid & 255, th = tid >> 8;
    f32x2 w2[31];
#pragma unroll
    for (int k = 0; k < 31; ++k) w2[k] = *(const f32x2*)(dw_w + k * 512 + 2 * p);
    const f32x2 bias = *(const f32x2*)(dw_b + 2 * p);
    LAS float* OUT = (LAS float*)(lds + CV_OUT_OFF);
    for (int item = blockIdx.x; item < M / CT; item += G) {
        const int tok0 = item * CT, s0 = tok0 % SEQ, bbase = tok0 - s0;
        {
            u32x4 sv[8];
#pragma unroll
            for (int e = 0; e < 8; ++e) { const int c = tid + 512 * e, r = c >> 6, ch = c & 63; const int s = s0 - 15 + r;
                sv[e] = (u32x4){0u, 0u, 0u, 0u};
                if (c < CV_IN_ROWS * 64 && s >= 0 && s < SEQ) sv[e] = *(const u32x4*)(U0 + (size_t)(bbase + s) * U0W + ch * 8); }
#pragma unroll
            for (int e = 0; e < 8; ++e) { const int c = tid + 512 * e, r = c >> 6, ch = c & 63;
                if (c < CV_IN_ROWS * 64) *(LAS u32x4*)(lds + r * 1024 + ch * 16) = sv[e]; }
        }
        __syncthreads();
        {
            f32x2 a2[16];
#pragma unroll
            for (int i = 0; i < 16; ++i) a2[i] = bias;
#pragma unroll
            for (int jr = 0; jr < 46; ++jr) {
                const unsigned w = *(const LAS unsigned*)(lds + (16 * th + jr) * 1024 + p * 4);
                const f32x2 x2 = {bflo(w), bfhi(w)};
#pragma unroll
                for (int i = 0; i < 16; ++i) { const int kk = jr - i; if (kk >= 0 && kk <= 30) a2[i] = __builtin_elementwise_fma(w2[kk], x2, a2[i]); }
            }
#pragma unroll
            for (int i = 0; i < 16; ++i) *(LAS f32x2*)(OUT + (16 * th + i) * 512 + 2 * p) = a2[i];
        }
        __syncthreads();
        for (int t = wid; t < CT; t += 8) {
            f32x4 a = *(const LAS f32x4*)(OUT + t * 512 + 4 * lane), b = *(const LAS f32x4*)(OUT + t * 512 + 256 + 4 * lane);
            const float mean = wave_sum((a[0] + a[1]) + (a[2] + a[3]) + (b[0] + b[1]) + (b[2] + b[3])) * (1.0f / 512.0f);
            a = a - mean; b = b - mean;
            const float var = wave_sum((a[0] * a[0] + a[1] * a[1]) + (a[2] * a[2] + a[3] * a[3]) + (b[0] * b[0] + b[1] * b[1]) + (b[2] * b[2] + b[3] * b[3])) * (1.0f / 512.0f);
            const float rs = 1.0f / sqrtf(var + EPS);
            const f32x4 ga = *(const f32x4*)(ln_g + 4 * lane), gb = *(const f32x4*)(ln_g + 256 + 4 * lane), ba = *(const f32x4*)(ln_b + 4 * lane), bb = *(const f32x4*)(ln_b + 256 + 4 * lane);
            float ya[4], yb[4];
#pragma unroll
            for (int j = 0; j < 4; ++j) { const float y = a[j] * rs * ga[j] + ba[j]; ya[j] = y * sigmoidf_(y); const float z = b[j] * rs * gb[j] + bb[j]; yb[j] = z * sigmoidf_(z); }
            bf16_t* orow = CAT + (size_t)(tok0 + t) * D;
            u32x2 wa; wa.x = cvt_pk_bf16(ya[0], ya[1]); wa.y = cvt_pk_bf16(ya[2], ya[3]); *(u32x2*)(orow + 4 * lane) = wa;
            u32x2 wb; wb.x = cvt_pk_bf16(yb[0], yb[1]); wb.y = cvt_pk_bf16(yb[2], yb[3]); *(u32x2*)(orow + 256 + 4 * lane) = wb;
        }
#pragma unroll
        for (int c = tid; c < CT * 64; c += 512) { const int t = c >> 6, ch = (c & 63) * 8; const int s = s0 + t; const size_t row = (size_t)(tok0 + t);
            const bf16_t* cvp = U0 + row * U0W + 512 + ch;
            const u32x4 c0 = *(const u32x4*)cvp;
            u32x4 cm = (u32x4){0u, 0u, 0u, 0u}, cp = (u32x4){0u, 0u, 0u, 0u};
            if (s > 0) cm = *(const u32x4*)(cvp - U0W);
            if (s < SEQ - 1) cp = *(const u32x4*)(cvp + U0W);
            const u32x4 bg = *(const u32x4*)(U0 + row * U0W + 1024 + ch);
            float r[8];
#pragma unroll
            for (int q = 0; q < 4; ++q) {
                const float wm0 = sc_w[ch + 2 * q], wm1 = sc_w[ch + 2 * q + 1], wc0 = sc_w[512 + ch + 2 * q], wc1 = sc_w[512 + ch + 2 * q + 1], wp0 = sc_w[1024 + ch + 2 * q], wp1 = sc_w[1024 + ch + 2 * q + 1];
                r[2 * q] = bflo(bg[q]) * (wm0 * bflo(cm[q]) + wc0 * bflo(c0[q]) + wp0 * bflo(cp[q]));
                r[2 * q + 1] = bfhi(bg[q]) * (wm1 * bfhi(cm[q]) + wc1 * bfhi(c0[q]) + wp1 * bfhi(cp[q]));
            }
            u32x4 o; o.x = cvt_pk_bf16(r[0], r[1]); o.y = cvt_pk_bf16(r[2], r[3]); o.z = cvt_pk_bf16(r[4], r[5]); o.w = cvt_pk_bf16(r[6], r[7]);
            *(u32x4*)(CAT + row * D + 512 + ch) = o; }
    }
    __syncthreads();
}

constexpr int GL_QB = 0, GL_KB = 17408, GL_KET = 34816, GL_VT = 53248, GL_LA = 34816, GL_SC = 71680, GL_ST = 80896, GL_DEC = 115712, GL_GT = 116224;
#define MFMA16(a, b, c) __builtin_amdgcn_mfma_f32_16x16x32_bf16((a), (b), (c), 0, 0, 0)
__device__ __forceinline__ void gla_phase(LAS unsigned char* lds, const bf16_t* U, const float* wa2f, const float* ba2f, const float* wa2b, const float* ba2b, bf16_t* OD, int G, const int tid) {
    const int wid = __builtin_amdgcn_readfirstlane(tid >> 6), lane = tid & 63;
    const int l15 = lane & 15, l4 = lane >> 4;
    const float L2E = 1.4426950408889634f;
    for (int cid = blockIdx.x; cid < 256; cid += G) {
        const int vs = cid & 1, dir = (cid >> 1) & 1, h = (cid >> 2) & 3, b = cid >> 4;
        const float* wa2 = dir ? wa2b : wa2f; const float* ba2 = dir ? ba2b : ba2f;
        const int tr = wid >> 2, tc = wid & 3;
        bf16x8 wb;
#pragma unroll
        for (int j = 0; j < 8; ++j) wb[j] = (short)f2bf(wa2[(8 * (lane >> 5) + j) * 512 + h * 128 + 32 * tc + (lane & 31)]);
        const float zb = ba2[h * 128 + 32 * tc + (lane & 31)];
        f32x4 S[8];
#pragma unroll
        for (int i = 0; i < 8; ++i) S[i] = (f32x4){0.f, 0.f, 0.f, 0.f};
        for (int c = tid; c < 34816 / 16; c += 512) *(LAS u32x4*)(lds + GL_ST + c * 16) = (u32x4){0u, 0u, 0u, 0u};
        __syncthreads();
        bf16_t* od = OD + (size_t)dir * M * D;
        const size_t offg = (size_t)(32 * tr + (lane & 31)) * U1W + 3072 + dir * 16 + 8 * (lane >> 5);
        size_t offq[2];
#pragma unroll
        for (int e = 0; e < 2; ++e) { const int c = tid + 512 * e, t = c >> 4, kc = c & 15; offq[e] = (size_t)t * U1W + h * 128 + kc * 8; }
        size_t offv[2];
#pragma unroll
        for (int e = 0; e < 2; ++e) { const int c = tid + 512 * e, t = c & 63, vc = c >> 6; offv[e] = (size_t)t * U1W + 1024 + h * 256 + vs * 128 + vc * 8; }
        bf16x8 ga; u32x4 qreg[2], kreg[2], vreg[2];
        {
            const int n = dir ? 31 : 0; const bf16_t* base = U + ((size_t)b * SEQ + (size_t)n * 64) * U1W;
            ga = *(const bf16x8*)(base + offg);
#pragma unroll
            for (int e = 0; e < 2; ++e) { qreg[e] = *(const u32x4*)(base + offq[e]); kreg[e] = *(const u32x4*)(base + offq[e] + 512); vreg[e] = *(const u32x4*)(base + offv[e]); }
        }
        for (int step = 0; step < 32; ++step) {
            const int n = dir ? 31 - step : step; const size_t tok0 = (size_t)b * SEQ + (size_t)n * 64;
            u32x4 vcur[2];
            {
                f32x16 z;
#pragma unroll
                for (int i = 0; i < 16; ++i) z[i] = 0.f;
                z = __builtin_amdgcn_mfma_f32_32x32x16_bf16(ga, wb, z, 0, 0, 0);
#pragma unroll
                for (int e = 0; e < 2; ++e) { const int c = tid + 512 * e, t = c >> 4, kc = c & 15;
                    *(LAS u32x4*)(lds + GL_QB + t * 272 + kc * 16) = qreg[e]; *(LAS u32x4*)(lds + GL_KB + t * 272 + kc * 16) = kreg[e]; vcur[e] = vreg[e]; }
                const float nzb = zb * -L2E;
#pragma unroll
                for (int i = 0; i < 16; i += 2) {
                    f32x2 t = {z[i], z[i + 1]}; t = __builtin_elementwise_min(t * -L2E + nzb, (f32x2){126.f, 126.f});
                    f32x2 d; d.x = __builtin_amdgcn_exp2f(t.x); d.y = __builtin_amdgcn_exp2f(t.y); d = d + 1.0f;
                    f32x2 l; l.x = __builtin_amdgcn_logf(d.x); l.y = __builtin_amdgcn_logf(d.y); l = l * (-1.0f / 16.0f);
                    const int row = (i & 3) + 8 * (i >> 2) + 4 * (lane >> 5);
                    *(LAS float*)(lds + GL_LA + ((32 * tr + row) * 128 + 32 * tc + (lane & 31)) * 4) = l.x;
                    *(LAS float*)(lds + GL_LA + ((32 * tr + row + 1) * 128 + 32 * tc + (lane & 31)) * 4) = l.y; }
            }
            __syncthreads();
            const int kp = lane, tg = wid;
            f32x2 pc[8];
#pragma unroll
            for (int i = 0; i < 8; ++i) pc[i] = *(const LAS f32x2*)(lds + GL_LA + ((8 * tg + i) * 128 + 2 * kp) * 4);
            if (dir == 0) {
#pragma unroll
                for (int i = 1; i < 8; ++i) pc[i] += pc[i - 1];
                *(LAS f32x2*)(lds + GL_GT + (tg * 128 + 2 * kp) * 4) = pc[7];
            } else {
#pragma unroll
                for (int i = 6; i >= 0; --i) pc[i] += pc[i + 1];
                *(LAS f32x2*)(lds + GL_GT + (tg * 128 + 2 * kp) * 4) = pc[0];
            }
            __syncthreads();
            {
                const int sn = step < 31 ? step + 1 : step; const int nn = dir ? 31 - sn : sn; const bf16_t* base = U + ((size_t)b * SEQ + (size_t)nn * 64) * U1W;
                ga = *(const bf16x8*)(base + offg);
#pragma unroll
                for (int e = 0; e < 2; ++e) { qreg[e] = *(const u32x4*)(base + offq[e]); kreg[e] = *(const u32x4*)(base + offq[e] + 512); vreg[e] = *(const u32x4*)(base + offv[e]); }
            }
            {
                f32x2 tot = (f32x2){0.f, 0.f}, off = (f32x2){0.f, 0.f};
#pragma unroll
                for (int t = 0; t < 8; ++t) { const f32x2 g = *(const LAS f32x2*)(lds + GL_GT + (t * 128 + 2 * kp) * 4); tot += g; const bool take = dir == 0 ? (t < tg) : (t > tg); if (take) off += g; }
                f32x2 et; et.x = __builtin_amdgcn_exp2f(tot[0]); et.y = __builtin_amdgcn_exp2f(tot[1]);
                const float et0 = et.x, et1 = et.y;
                float ke0[8], ke1[8];
#pragma unroll
                for (int i = 0; i < 8; ++i) {
                    const f32x2 c = pc[i] + off;
                    f32x2 E, iE; E.x = __builtin_amdgcn_exp2f(c.x); E.y = __builtin_amdgcn_exp2f(c.y); iE.x = __builtin_amdgcn_rcpf(E.x); iE.y = __builtin_amdgcn_rcpf(E.y);
                    LAS unsigned* qp = (LAS unsigned*)(lds + GL_QB + (8 * tg + i) * 272 + kp * 4);
                    LAS unsigned* kq = (LAS unsigned*)(lds + GL_KB + (8 * tg + i) * 272 + kp * 4);
                    const unsigned qw = *qp, kw = *kq;
                    const f32x2 qt = (f32x2){bflo(qw), bfhi(qw)} * E, kt = (f32x2){bflo(kw), bfhi(kw)} * iE, ke = kt * et;
                    *qp = cvt_pk_bf16(qt.x, qt.y);
                    *kq = cvt_pk_bf16(kt.x, kt.y);
                    ke0[i] = ke.x; ke1[i] = ke.y;
                }
                *(LAS u32x4*)(lds + GL_KET + (2 * kp) * 144 + tg * 16) = (u32x4){cvt_pk_bf16(ke0[0], ke0[1]), cvt_pk_bf16(ke0[2], ke0[3]), cvt_pk_bf16(ke0[4], ke0[5]), cvt_pk_bf16(ke0[6], ke0[7])};
                *(LAS u32x4*)(lds + GL_KET + (2 * kp + 1) * 144 + tg * 16) = (u32x4){cvt_pk_bf16(ke1[0], ke1[1]), cvt_pk_bf16(ke1[2], ke1[3]), cvt_pk_bf16(ke1[4], ke1[5]), cvt_pk_bf16(ke1[6], ke1[7])};
                if (tg == 0) *(LAS f32x2*)(lds + GL_DEC + 2 * kp * 4) = (f32x2){et0, et1};
#pragma unroll
                for (int e = 0; e < 2; ++e) { const int c = tid + 512 * e, t = c & 63, vc = c >> 6;
#pragma unroll
                    for (int x = 0; x < 4; ++x) { const unsigned w = vcur[e][x];
                        *(LAS bf16_t*)(lds + GL_VT + (vc * 8 + 2 * x) * 144 + t * 2) = (bf16_t)(w & 0xffffu);
                        *(LAS bf16_t*)(lds + GL_VT + (vc * 8 + 2 * x + 1) * 144 + t * 2) = (bf16_t)(w >> 16); } }
            }
            __syncthreads();
            f32x4 oT[4];
            {
                bf16x8 fa[2][4], fb[2][4];
#pragma unroll
                for (int e = 0; e < 2; ++e) { const int t = 2 * wid + e, tj = t >> 2, ti = t & 3;
#pragma unroll
                    for (int kk = 0; kk < 4; ++kk) {
                        fa[e][kk] = *(const LAS bf16x8*)(lds + GL_KB + (16 * tj + l15) * 272 + (32 * kk + 8 * l4) * 2);
                        fb[e][kk] = *(const LAS bf16x8*)(lds + GL_QB + (16 * ti + l15) * 272 + (32 * kk + 8 * l4) * 2); } }
                __builtin_amdgcn_sched_barrier(0);
#pragma unroll
                for (int e = 0; e < 2; ++e) { const int t = 2 * wid + e, tj = t >> 2, ti = t & 3;
                    f32x4 sc = (f32x4){0.f, 0.f, 0.f, 0.f};
#pragma unroll
                    for (int kk = 0; kk < 4; ++kk) sc = MFMA16(fa[e][kk], fb[e][kk], sc);
                    const int i = 16 * ti + l15, j0 = 16 * tj + 4 * l4;
                    float m[4];
#pragma unroll
                    for (int x = 0; x < 4; ++x) { const int j = j0 + x; const bool keep = dir == 0 ? (j <= i) : (j >= i); m[x] = keep ? sc[x] : 0.f; }
                    u32x2 w; w.x = cvt_pk_bf16(m[0], m[1]); w.y = cvt_pk_bf16(m[2], m[3]);
                    *(LAS u32x2*)(lds + GL_SC + i * 144 + j0 * 2) = w; }
                bf16x8 sa[4], bq[4][4];
#pragma unroll
                for (int kk = 0; kk < 4; ++kk) sa[kk] = *(const LAS bf16x8*)(lds + GL_ST + (16 * wid + l15) * 272 + (32 * kk + 8 * l4) * 2);
#pragma unroll
                for (int ti = 0; ti < 4; ++ti)
#pragma unroll
                    for (int kk = 0; kk < 4; ++kk) bq[ti][kk] = *(const LAS bf16x8*)(lds + GL_QB + (16 * ti + l15) * 272 + (32 * kk + 8 * l4) * 2);
                __builtin_amdgcn_sched_barrier(0);
#pragma unroll
                for (int ti = 0; ti < 4; ++ti) { oT[ti] = (f32x4){0.f, 0.f, 0.f, 0.f};
#pragma unroll
                    for (int kk = 0; kk < 4; ++kk) oT[ti] = MFMA16(sa[kk], bq[ti][kk], oT[ti]); }
            }
            __syncthreads();
            {
                bf16x8 va[2], bs[4][2];
#pragma unroll
                for (int kk = 0; kk < 2; ++kk) va[kk] = *(const LAS bf16x8*)(lds + GL_VT + (16 * wid + l15) * 144 + (32 * kk + 8 * l4) * 2);
#pragma unroll
                for (int ti = 0; ti < 4; ++ti)
#pragma unroll
                    for (int kk = 0; kk < 2; ++kk) bs[ti][kk] = *(const LAS bf16x8*)(lds + GL_SC + (16 * ti + l15) * 144 + (32 * kk + 8 * l4) * 2);
                __builtin_amdgcn_sched_barrier(0);
#pragma unroll
                for (int ti = 0; ti < 4; ++ti) {
#pragma unroll
                    for (int kk = 0; kk < 2; ++kk) oT[ti] = MFMA16(va[kk], bs[ti][kk], oT[ti]);
                    u32x2 w; w.x = cvt_pk_bf16(oT[ti][0], oT[ti][1]); w.y = cvt_pk_bf16(oT[ti][2], oT[ti][3]);
                    *(u32x2*)(od + (tok0 + 16 * ti + l15) * D + h * 256 + vs * 128 + 16 * wid + 4 * l4) = w; }
                const f32x4 dec = *(const LAS f32x4*)(lds + GL_DEC + (16 * wid + 4 * l4) * 4);
                bf16x8 ka[2], bv[8][2];
#pragma unroll
                for (int kk = 0; kk < 2; ++kk) ka[kk] = *(const LAS bf16x8*)(lds + GL_KET + (16 * wid + l15) * 144 + (32 * kk + 8 * l4) * 2);
#pragma unroll
                for (int tv = 0; tv < 8; ++tv)
#pragma unroll
                    for (int kk = 0; kk < 2; ++kk) bv[tv][kk] = *(const LAS bf16x8*)(lds + GL_VT + (16 * tv + l15) * 144 + (32 * kk + 8 * l4) * 2);
                __builtin_amdgcn_sched_barrier(0);
#pragma unroll
                for (int tv = 0; tv < 8; ++tv) { S[tv] = S[tv] * dec;
#pragma unroll
                    for (int kk = 0; kk < 2; ++kk) S[tv] = MFMA16(ka[kk], bv[tv][kk], S[tv]);
                    u32x2 w; w.x = cvt_pk_bf16(S[tv][0], S[tv][1]); w.y = cvt_pk_bf16(S[tv][2], S[tv][3]);
                    *(LAS u32x2*)(lds + GL_ST + (16 * tv + l15) * 272 + (16 * wid + 4 * l4) * 2) = w; }
            }
            __syncthreads();
        }
    }
}

#define XB_TMO      128
#define XB_XCNT(j)  (256  + 64 * (j))
#define XB_XSUB(j)  (1280 + 64 * (j))
#define XB_XGEN(j)  (2304 + 64 * (j))
#define XB_TOP      3328
#define XB_TOPGEN   3392
#define XCD_BAR_WORDS 3456
#define XB_SPIN_CAP (1u << 18)

__device__ __forceinline__ unsigned xb_ld(unsigned* p)              { return __hip_atomic_load(p, __ATOMIC_RELAXED, __HIP_MEMORY_SCOPE_AGENT); }
__device__ __forceinline__ unsigned xb_add(unsigned* p, unsigned v) { return __hip_atomic_fetch_add(p, v, __ATOMIC_RELAXED, __HIP_MEMORY_SCOPE_AGENT); }
__device__ __forceinline__ unsigned xb_xcc_id() { return (unsigned)__builtin_amdgcn_s_getreg((3 << 11) | 20) & 0xFu; }
#define XB_SPIN(cond, bar) do { unsigned _sp = 0; while (cond) { __builtin_amdgcn_s_sleep(1); \
    if ((++_sp & 255u) == 0u) { if (xb_ld(&(bar)[XB_TMO])) break; if (_sp > XB_SPIN_CAP) { atomicAdd(&(bar)[XB_TMO], 1u); break; } } } } while (0)

struct XcdBarrier {
    unsigned* bar; unsigned x;
    volatile LAS unsigned* st;
};

__device__ __forceinline__ XcdBarrier xcd_barrier_post(unsigned* bar, volatile LAS unsigned* st) {
    XcdBarrier b; b.bar = bar; b.x = xb_xcc_id(); b.st = st;
    if (threadIdx.x == 0) (void)xb_add(&bar[XB_XCNT(b.x)], 1u);
    return b;
}
__device__ __forceinline__ void xcd_barrier_complete(unsigned* bar, unsigned x, unsigned& nloc, unsigned& nx) {
    const unsigned G = gridDim.x * gridDim.y * gridDim.z;
    unsigned sum, cnt, mine, sp = 0u;
    for (;;) {
        sum = 0u; cnt = 0u; mine = 0u;
#pragma unroll
        for (unsigned j = 0; j < 16; ++j) { const unsigned c = xb_ld(&bar[XB_XCNT(j)]); sum += c; cnt += (c > 0u) ? 1u : 0u; mine = (j == x) ? c : mine; }
        if (sum == G) break;
        __builtin_amdgcn_s_sleep(1);
        if ((++sp & 255u) == 0u) { if (xb_ld(&bar[XB_TMO])) break; if (sp > XB_SPIN_CAP) { atomicAdd(&bar[XB_TMO], 1u); break; } }
    }
    nloc = mine > 0u ? mine : 1u; nx = cnt > 0u ? cnt : 1u;
}

__device__ __forceinline__ void xcd_barrier(const XcdBarrier& b) {
    asm volatile("s_waitcnt vmcnt(0)" ::: "memory");
    __syncthreads();
    if (threadIdx.x == 0) {
        unsigned* bar = b.bar;
        __builtin_amdgcn_s_waitcnt(0);
        unsigned nloc = b.st[0], nx = b.st[1];
        if (nloc == 0u) { xcd_barrier_complete(bar, b.x, nloc, nx); b.st[0] = nloc; b.st[1] = nx; }
        const unsigned old = xb_add(&bar[XB_XSUB(b.x)], 1u);
        const unsigned gen = old / nloc;
        if (old + 1u == (gen + 1u) * nloc) {
            __builtin_amdgcn_fence(__ATOMIC_RELEASE, "agent");
            asm volatile("s_waitcnt vmcnt(0)" ::: "memory");
            const unsigned og = xb_add(&bar[XB_TOP], 1u);
            const unsigned tg = og / nx;
            if (og + 1u == (tg + 1u) * nx) xb_add(&bar[XB_TOPGEN], 1u);
            else XB_SPIN(xb_ld(&bar[XB_TOPGEN]) == tg, bar);
            __builtin_amdgcn_fence(__ATOMIC_ACQUIRE, "agent");
            xb_add(&bar[XB_XGEN(b.x)], 1u);
            asm volatile("s_waitcnt vmcnt(0)" ::: "memory");
        } else {
            XB_SPIN(xb_ld(&bar[XB_XGEN(b.x)]) == gen, bar);
            __builtin_amdgcn_fence(__ATOMIC_ACQUIRE, "agent");
            asm volatile("s_waitcnt vmcnt(0)" ::: "memory");
        }
    }
    __syncthreads();
}

struct Args { const float* in[21]; float* out; unsigned char* ws; int nph, pad; unsigned char pl[32]; };
constexpr int N_PHASES = 12;

__global__ void __launch_bounds__(512, 2) fwd_kernel(Args args) {
    extern __shared__ __attribute__((aligned(16))) unsigned char lds_raw[];
    LAS unsigned char* lds = (LAS unsigned char*)lds_raw;
    const int G = gridDim.x;
    const int bx = blockIdx.x;
    const int vcu = (G % 8 == 0) ? (bx % 8) * (G / 8) + bx / 8 : bx;
    const int ngw = G * 8;
    unsigned char* ws = args.ws;
    const float* x = args.in[0];
    float* xo = args.out;
    float* SSQ = (float*)(ws + WS_SSQ);
    bf16_t* H = (bf16_t*)(ws + WS_H); bf16_t* MB = (bf16_t*)(ws + WS_MB); bf16_t* UB = (bf16_t*)(ws + WS_U); bf16_t* CAT = (bf16_t*)(ws + WS_CAT); bf16_t* OD = (bf16_t*)(ws + WS_OD);

    volatile LAS unsigned* bst = (volatile LAS unsigned*)(lds + 131072 + 1024);
    if (threadIdx.x < 2) bst[threadIdx.x] = 0u;
    __syncthreads();
    const XcdBarrier xbar = xcd_barrier_post((unsigned*)(ws + WS_BAR), bst);
    for (int ip = 0; ip < args.nph; ++ip) {
        const int pi = args.pl[ip];
        if (ip > 0) { if (args.pad) cg::this_grid().sync(); else xcd_barrier(xbar); }
        int tid = threadIdx.x; asm volatile("" : "+v"(tid));
        const int lane = tid & 63, wave = __builtin_amdgcn_readfirstlane(tid >> 6);
        const int gw = vcu * 8 + wave;
        const bf16_t* gA = nullptr; const bf16_t* gB = nullptr; int gN = 0, gK = 0, ekind = 0, eld = 0; bf16_t* eO = nullptr;
        int fz = -1;
        switch (pi) {
            case 1:  gA = H;   gB = (const bf16_t*)(ws + WS_W0IN);  gN = 2560; gK = 1024; ekind = 0; eO = UB;  eld = U0W; break;
            case 3:  gA = CAT; gB = (const bf16_t*)(ws + WS_W0OUT); gN = 1024; gK = 1024; fz = 0; break;
            case 4:  gA = (const bf16_t*)xo; gB = (const bf16_t*)(ws + WS_WGU0);  gN = 5632; gK = 1024; ekind = 1; eO = UB;  eld = DFF; break;
            case 5:  gA = UB;  gB = (const bf16_t*)(ws + WS_WDN0);  gN = 1024; gK = DFF;  fz = 1; break;
            case 6:  gA = (const bf16_t*)xo; gB = (const bf16_t*)(ws + WS_W1IN);  gN = U1W;  gK = 1024; ekind = 2; eO = UB;  eld = U1W; break;
            case 9:  gA = CAT; gB = (const bf16_t*)(ws + WS_W1OUT); gN = 1024; gK = 1024; fz = 2; break;
            case 10: gA = MB;  gB = (const bf16_t*)(ws + WS_WGU1);  gN = 5632; gK = 1024; ekind = 1; eO = UB;  eld = DFF; break;
            case 11: gA = UB;  gB = (const bf16_t*)(ws + WS_WDN1);  gN = 1024; gK = DFF;  fz = 3; break;
            case 12: gA = UB;  gB = (const bf16_t*)(ws + WS_WDN1);  gN = 1024; gK = DFF;  ekind = 2; eO = MB;  eld = D; break;
            case 13: gA = CAT; gB = (const bf16_t*)(ws + WS_W1OUT); gN = 1024; gK = 1024; ekind = 2; eO = MB;  eld = D; break;
            default: break;
        }
        if (gA && fz < 0) {
            pg8::Gemm g{gA, gB, M, gN, gK}; pg8::StaticOrder S; S.init(M, gN, G, bx);
            LAS float* rstab = (LAS float*)(lds + 131072 + 2048);
            if (tid < 256) {
                f32x4 qv[12];
#pragma unroll
                for (int i = 0; i < 12; ++i) { const int pmi = pg8::unit_pm(i, M / 256, gN / 256, G, bx); qv[i] = (f32x4){1024.f, 0.f, 0.f, 0.f}; if (pmi >= 0) qv[i] = *(const f32x4*)(SSQ + (size_t)(pmi * 256 + tid) * 4); }
#pragma unroll
                for (int i = 0; i < 12; ++i) rstab[i * 256 + tid] = 1.0f / sqrtf(((qv[i][0] + qv[i][1]) + (qv[i][2] + qv[i][3])) * (1.0f / 1024.0f) + EPS);
            }
            __syncthreads();
            pg8::EpiGen E{eO, eld, ekind, rstab};
            for (int i = 0; i < ((bx >> 3) & 7); ++i) __builtin_amdgcn_s_sleep(16);
            pg8::gemm_phase<pg8::EpiGen, pg8::StaticOrder, true, true, false>(lds, g, S, E, tid);
            continue;
        }
        if (gA) {
            const float* gpost = fz == 0 ? args.in[2] : fz == 1 ? args.in[4] : fz == 2 ? args.in[2] + D : args.in[4] + D;
            const void* xi = fz == 0 ? (const void*)x : fz == 3 ? (const void*)MB : (const void*)xo;
            void* xw = fz == 2 ? (void*)MB : (void*)xo;
            pg8::EpiFused E{xi, xw, fz == 0 ? 0 : 1, fz == 3 ? 0 : 1, gpost,
                            (float*)(ws + WS_XB + (size_t)fz * XB_BANK), (unsigned*)(ws + WS_CTL) + (size_t)fz * 128 * 64, fz == 3 ? nullptr : SSQ};
            for (int i = 0; i < ((bx >> 3) & 7); ++i) __builtin_amdgcn_s_sleep(16);
            pg8::Gemm g{gA, gB, M, gN, gK};
            const int rounds = (128 * 4 + G - 1) / G;
            for (int r = 0; r < rounds; ++r) {
                pg8::OneUnit S; S.so.init(M, gN, G, bx); S.round = r;
                pg8::gemm_phase<pg8::EpiFused, pg8::OneUnit, false, true, true>(lds, g, S, E, tid);
            }
            continue;
        }
        if (pi == 0) {
            LAS float* scr = (LAS float*)(lds + wave * 16384);
            int it = gw;
#define TR_MAT(Wp, Gp, Kk, Ns, WTp, Nd, kd) { const int items = ((Kk) / 64) * ((Nd) / 32); for (; it < items; it += 2 * ngw) p0_transpose_item2((Wp), (Gp), (Kk), (Ns), (bf16_t*)(WTp), (kd), scr, it, it + ngw < items ? it + ngw : -1, (Nd), lane); if (it - ngw >= items) it -= ngw; it -= items; }
            TR_MAT(args.in[5], args.in[1], 1024, 2560, ws + WS_W0IN, 2560, 0)
            TR_MAT(args.in[11], nullptr, 1024, 1024, ws + WS_W0OUT, 1024, 2)
            TR_MAT(args.in[19], args.in[3], 1024, 5632, ws + WS_WGU0, 5632, 1)
            TR_MAT(args.in[19] + (size_t)1024 * 5632, args.in[3] + D, 1024, 5632, ws + WS_WGU1, 5632, 1)
            TR_MAT(args.in[20], nullptr, DFF, 1024, ws + WS_WDN0, 1024, 2)
            TR_MAT(args.in[20] + (size_t)DFF * 1024, nullptr, DFF, 1024, ws + WS_WDN1, 1024, 2)
            TR_MAT(args.in[12], args.in[1] + D, 1024, 3104, ws + WS_W1IN, U1W, 3)
            TR_MAT(args.in[18], nullptr, 1024, 1024, ws + WS_W1OUT, 1024, 2)
#undef TR_MAT
            cvt_phase(x, H, SSQ, gw, ngw, lane);
            __syncthreads();
        } else if (pi == 2) {
            conv_phase(lds, UB, args.in[6], args.in[7], args.in[8], args.in[9], args.in[10], CAT, G, tid);
        } else if (pi == 7) {
            gla_phase(lds, UB, args.in[13], args.in[14], args.in[15], args.in[16], OD, G, tid);
        } else if (pi == 8) {
            gla_combine_phase(OD, UB, args.in[17], CAT, gw, ngw, lane);
        }
    }
}

extern "C" void kernel_launch(void* const* d_in, const int* in_sizes, int n_in, void* d_out, int out_size, void* d_ws, size_t ws_size, hipStream_t stream) {
    static int grid = 0;
    if (grid == 0) {
        if (n_in != 21 || out_size != M * D || ws_size < WS_END) { fprintf(stderr, "kernel_launch: unexpected problem (n_in %d out %d ws %zu)\n", n_in, out_size, ws_size); grid = -1; return; }
        int dev = 0, cus = 0, per_cu = 0;
        hipGetDevice(&dev);
        hipDeviceGetAttribute(&cus, hipDeviceAttributeMultiprocessorCount, dev);
        if (hipFuncSetAttribute((const void*)fwd_kernel, hipFuncAttributeMaxDynamicSharedMemorySize, LDS_BYTES) != hipSuccess) { fprintf(stderr, "kernel_launch: hipFuncSetAttribute failed\n"); grid = -1; return; }
        if (hipOccupancyMaxActiveBlocksPerMultiprocessor(&per_cu, (const void*)fwd_kernel, 512, LDS_BYTES) != hipSuccess || per_cu < 1) { fprintf(stderr, "kernel_launch: occupancy query gave %d\n", per_cu); per_cu = 1; }
        (void)hipGetLastError();
        grid = cus * per_cu;
    }
    if (grid < 0) return;
    if (hipMemsetAsync((char*)d_ws + WS_CTL, 0, CTL_BYTES, stream) != hipSuccess) { fprintf(stderr, "kernel_launch: memset failed\n"); return; }
    Args a{};
    for (int i = 0; i < 21; ++i) a.in[i] = (const float*)d_in[i];
    a.out = (float*)d_out; a.ws = (unsigned char*)d_ws;
#if MK_ONE_LAUNCH
#ifndef PROBE_DUP
#define PROBE_DUP -1
#endif

    { int n = 0; for (int p = 0; p < N_PHASES; ++p) { a.pl[n++] = (unsigned char)p; if (p == PROBE_DUP) a.pl[n++] = (unsigned char)p; } a.nph = n; }
#ifdef PROBE_EXTRA
    a.pl[a.nph++] = PROBE_EXTRA;
#endif
#ifdef PROBE_NULLS
    for (int i = 0; i < PROBE_NULLS; ++i) a.pl[a.nph++] = 15;
#endif
    void* kargs[] = {&a};
    hipError_t e = hipLaunchCooperativeKernel((const void*)fwd_kernel, dim3(grid), dim3(512), kargs, LDS_BYTES, stream);
    if (e != hipSuccess) fprintf(stderr, "cooperative launch failed: %s (grid %d)\n", hipGetErrorString(e), grid);
#else
    for (int p = 0; p < N_PHASES; ++p) {
        a.nph = 1; a.pl[0] = (unsigned char)p;
        hipLaunchKernelGGL(fwd_kernel, dim3(grid), dim3(512), LDS_BYTES, stream, a);
        if (p == PROBE_P) hipLaunchKernelGGL(fwd_kernel, dim3(grid), dim3(512), LDS_BYTES, stream, a);
    }
#endif
}
```
